# Optimizing an MI355X kernel written in HIP

```python
import math
import jax, jax.numpy as jnp
from jax import lax
import numpy as np

D_MODEL = 4096
BATCH = 32
SEQ = 256
DEPTH = 1
DEC_BATCH = 4
DEC_SEQ = 4096
PAST_LEN = 512

GRID_W = 64
ATT_WIDTH = D_MODEL // 2
V_HD = 256
QK_HD = V_HD // 2
N_ATT_HEADS = ATT_WIDTH // V_HD
AXIS_DIM = QK_HD // 2
ROPE_BASE = 10000.0
Q_BLOCK = 128
D_INNER = D_MODEL - ATT_WIDTH
SSM_HD = 64
N_SSM_HEADS = D_INNER // SSM_HD
N_GROUPS = 4
HEADS_PER_GROUP = N_SSM_HEADS // N_GROUPS
D_STATE = 128
CONV_K = 5
CHUNK = 128
D_FF = 4 * D_MODEL
RMS_EPS = 1e-6

Q_COLS = N_ATT_HEADS * 2 * QK_HD
K_COLS = N_ATT_HEADS * 2 * QK_HD
V_COLS = N_ATT_HEADS * V_HD
Z_COLS = D_INNER
XBC_COLS = D_INNER + 2 * N_GROUPS * D_STATE
DT_COLS = 2 * N_SSM_HEADS
IN_COLS = Q_COLS + K_COLS + V_COLS + Z_COLS + XBC_COLS + DT_COLS

kernel_name = "hymba_diffattn_bissd_sandwich_adaln"

F32 = jnp.float32


def rmsnorm(x, g, eps=RMS_EPS):
    xf = x.astype(F32)
    y = xf * lax.rsqrt(jnp.mean(xf * xf, axis=-1, keepdims=True) + eps)
    return y.astype(x.dtype) * g


def axial_rope(x):
    L = x.shape[1]
    rows = L // GRID_W
    row = jnp.repeat(jnp.arange(rows, dtype=F32), GRID_W)
    col = jnp.tile(jnp.arange(GRID_W, dtype=F32), rows)
    inv = 1.0 / (ROPE_BASE ** (jnp.arange(0, AXIS_DIM, 2, dtype=F32) / AXIS_DIM))
    half = AXIS_DIM // 2

    def rot(xa, pos):
        ang = pos[:, None] * inv[None, :]
        cos = jnp.cos(ang)[None, :, None, None, :].astype(x.dtype)
        sin = jnp.sin(ang)[None, :, None, None, :].astype(x.dtype)
        x1, x2 = xa[..., :half], xa[..., half:]
        return jnp.concatenate([x1 * cos - x2 * sin, x1 * sin + x2 * cos], axis=-1)

    return jnp.concatenate([rot(x[..., :AXIS_DIM], row), rot(x[..., AXIS_DIM:], col)], axis=-1)


def diff_attention(q, k, v, lam):
    b, Lq = q.shape[:2]
    nb = Lq // Q_BLOCK
    qb = jnp.swapaxes(q.reshape(b, nb, Q_BLOCK, N_ATT_HEADS, 2, QK_HD), 0, 1)
    scale = QK_HD ** -0.5

    def block(qi):
        s = jnp.einsum('bqhjd,bkhjd->bhjqk', qi, k).astype(F32) * scale
        pr = jax.nn.softmax(s, axis=-1)
        a = pr[:, :, 0] - lam * pr[:, :, 1]
        return jnp.einsum('bhqk,bkhv->bqhv', a.astype(v.dtype), v)

    o = lax.map(block, qb)
    return jnp.swapaxes(o, 0, 1).reshape(b, Lq, N_ATT_HEADS, V_HD)


def centred_conv(x, w, bias):
    L = x.shape[1]
    pad = CONV_K // 2
    xp = jnp.pad(x, ((0, 0), (pad, pad), (0, 0)))
    out = bias
    for j in range(CONV_K):
        out = out + w[j] * xp[:, j:j + L]
    return out


def ssd_scan(x, dt, A, Bm, Cm, init_state):
    b, L, G, HG, P = x.shape
    N = Bm.shape[-1]
    nc = L // CHUNK
    xf = x.astype(F32).reshape(b, nc, CHUNK, G, HG, P)
    dtc = dt.reshape(b, nc, CHUNK, G, HG)
    Bc = Bm.astype(F32).reshape(b, nc, CHUNK, G, N)
    Cc = Cm.astype(F32).reshape(b, nc, CHUNK, G, N)
    cs = jnp.cumsum(dtc * A, axis=2)
    seg = cs[:, :, :, None] - cs[:, :, None, :]
    causal = jnp.tril(jnp.ones((CHUNK, CHUNK), dtype=bool))[:, :, None, None]
    Lm = jnp.where(causal, jnp.exp(jnp.where(causal, seg, 0.0)), 0.0)
    cb = jnp.einsum('bclgn,bcsgn->bclsg', Cc, Bc)
    wts = cb[..., None] * Lm * dtc[:, :, None]
    y_diag = jnp.einsum('bclsgh,bcsghp->bclghp', wts, xf)
    decay_s = jnp.exp(cs[:, :, -1:] - cs)
    states = jnp.einsum('bcsgn,bcsghp->bcghpn', Bc, xf * (decay_s * dtc)[..., None])
    chunk_decay = jnp.exp(cs[:, :, -1])

    def step(carry, inp):
        st, dec = inp
        return carry * dec[..., None, None] + st, carry

    final, prev = lax.scan(step, init_state.astype(F32),
                           (jnp.moveaxis(states, 1, 0), jnp.moveaxis(chunk_decay, 1, 0)))
    prev = jnp.moveaxis(prev, 0, 1)
    y_off = jnp.einsum('bclgn,bcghpn->bclghp', Cc, prev) * jnp.exp(cs)[..., None]
    return (y_diag + y_off).reshape(b, L, G, HG, P), final


def token_mixers(h, p, layer_idx, ctx_k, ctx_v, init_f, init_b):
    latent = ctx_k is not None
    b, L, _ = h.shape
    proj = h @ p['w_in']
    o1 = Q_COLS
    o2 = o1 + K_COLS
    o3 = o2 + V_COLS
    o4 = o3 + Z_COLS
    o5 = o4 + XBC_COLS
    q = proj[..., :o1].reshape(b, L, N_ATT_HEADS, 2, QK_HD)
    k = proj[..., o1:o2].reshape(b, L, N_ATT_HEADS, 2, QK_HD)
    v = proj[..., o2:o3].reshape(b, L, N_ATT_HEADS, V_HD)
    z = proj[..., o3:o4]
    xbc = proj[..., o4:o5]
    dt_raw = proj[..., o5:]

    if latent:
        q_use = axial_rope(q)
        k_all = jnp.concatenate([ctx_k, axial_rope(k)], axis=1)
        v_all = jnp.concatenate([ctx_v, v], axis=1)
    else:
        q_use, k_all, v_all = q, k, v
    lam_init = 0.8 - 0.6 * math.exp(-0.3 * layer_idx)
    lam = (jnp.exp(jnp.sum(p['lq1'].astype(F32) * p['lk1'].astype(F32)))
           - jnp.exp(jnp.sum(p['lq2'].astype(F32) * p['lk2'].astype(F32))) + lam_init)
    o_att = diff_attention(q_use, k_all, v_all, lam)
    o_att = (rmsnorm(o_att, p['g_subln']) * (1.0 - lam_init)).reshape(b, L, ATT_WIDTH)

    xbc = jax.nn.silu(centred_conv(xbc, p['conv_w'], p['conv_b']))
    xs = xbc[..., :D_INNER].reshape(b, L, N_GROUPS, HEADS_PER_GROUP, SSM_HD)
    Bm = xbc[..., D_INNER:D_INNER + N_GROUPS * D_STATE].reshape(b, L, N_GROUPS, D_STATE)
    Cm = xbc[..., D_INNER + N_GROUPS * D_STATE:].reshape(b, L, N_GROUPS, D_STATE)
    dt = jax.nn.softplus(dt_raw.astype(F32).reshape(b, L, 2, N_GROUPS, HEADS_PER_GROUP)
                         + p['dt_bias'].astype(F32).reshape(2, N_GROUPS, HEADS_PER_GROUP))
    A = -jnp.exp(p['a_log'].astype(F32)).reshape(2, N_GROUPS, HEADS_PER_GROUP)
    y_f, fin_f = ssd_scan(xs, dt[:, :, 0], A[0], Bm, Cm, init_f)
    y_b, fin_b = ssd_scan(jnp.flip(xs, 1), jnp.flip(dt[:, :, 1], 1), A[1],
                          jnp.flip(Bm, 1), jnp.flip(Cm, 1), init_b)
    y = (y_f + jnp.flip(y_b, 1)).astype(h.dtype) \
        + p['d_skip'].reshape(N_GROUPS, HEADS_PER_GROUP)[..., None] * xs
    y = y.reshape(b, L, D_INNER) * jax.nn.silu(z)
    y = rmsnorm(y.reshape(b, L, N_GROUPS, D_INNER // N_GROUPS),
                p['g_ssm_norm'].reshape(N_GROUPS, D_INNER // N_GROUPS)).reshape(b, L, D_INNER)

    out = jnp.concatenate([o_att, y], axis=-1) @ p['w_out']
    return out, (k, v, fin_f, fin_b)


def trunk_layer(x, c_vec, p, layer_idx, ctx_k, ctx_v, init_f, init_b):
    mod = (jax.nn.silu(c_vec) @ p['w_ada'] + p['b_ada'])[:, None, :]
    sh_a, sc_a, g_a, sh_m, sc_m, g_m = jnp.split(mod, 6, axis=-1)
    h = rmsnorm(x, p['g_mix_pre']) * (1.0 + sc_a) + sh_a
    mix, ctx_t = token_mixers(h, p, layer_idx, ctx_k, ctx_v, init_f, init_b)
    x = x + g_a * rmsnorm(mix, p['g_mix_post'])
    h = rmsnorm(x, p['g_mlp_pre']) * (1.0 + sc_m) + sh_m
    m = jnp.square(jax.nn.relu(h @ p['w_up'])) @ p['w_down']
    x = x + g_m * rmsnorm(m, p['g_mlp_post'])
    return x, ctx_t


def setup_inputs(seed: int = 0) -> dict:
    key = jax.random.key(seed)
    ks = jax.random.split(key, 32)
    nrm = lambda k, shape, s=1.0: jax.random.normal(k, shape, F32) * s
    dt0 = jnp.exp(jax.random.uniform(ks[20], (DEPTH, 2, N_SSM_HEADS), F32)
                  * (math.log(0.1) - math.log(0.001)) + math.log(0.001))
    return {
        'x_prompt': nrm(ks[0], (BATCH, SEQ, D_MODEL)),
        'x_sample': nrm(ks[1], (DEC_BATCH, DEC_SEQ, D_MODEL)),
        'c': nrm(ks[2], (DEC_BATCH, D_MODEL)),
        'cache_k': nrm(ks[3], (DEC_BATCH, DEPTH, PAST_LEN, N_ATT_HEADS, 2, QK_HD)),
        'cache_v': nrm(ks[4], (DEC_BATCH, DEPTH, PAST_LEN, N_ATT_HEADS, V_HD)),
        'state_ssm_fwd': nrm(ks[5], (DEC_BATCH, DEPTH, N_SSM_HEADS, SSM_HD, D_STATE), 0.5),
        'state_ssm_bwd': nrm(ks[6], (DEC_BATCH, DEPTH, N_SSM_HEADS, SSM_HD, D_STATE), 0.5),
        'c_ctx': nrm(ks[7], (D_MODEL,)),
        'w_ada': nrm(ks[8], (DEPTH, D_MODEL, 6 * D_MODEL), 0.5 * D_MODEL ** -0.5),
        'b_ada': nrm(ks[9], (DEPTH, 6 * D_MODEL), 0.02),
        'g_mix_pre': 1.0 + nrm(ks[10], (DEPTH, D_MODEL), 0.02),
        'g_mix_post': 1.0 + nrm(ks[11], (DEPTH, D_MODEL), 0.02),
        'g_mlp_pre': 1.0 + nrm(ks[12], (DEPTH, D_MODEL), 0.02),
        'g_mlp_post': 1.0 + nrm(ks[13], (DEPTH, D_MODEL), 0.02),
        'w_in': nrm(ks[14], (DEPTH, D_MODEL, IN_COLS), D_MODEL ** -0.5),
        'lambda_q1': nrm(ks[15], (DEPTH, QK_HD), 0.1),
        'lambda_k1': nrm(ks[16], (DEPTH, QK_HD), 0.1),
        'lambda_q2': nrm(ks[17], (DEPTH, QK_HD), 0.1),
        'lambda_k2': nrm(ks[18], (DEPTH, QK_HD), 0.1),
        'g_subln': 1.0 + nrm(ks[19], (DEPTH, V_HD), 0.02),
        'conv_w': nrm(ks[21], (DEPTH, CONV_K, XBC_COLS), CONV_K ** -0.5),
        'conv_b': nrm(ks[22], (DEPTH, XBC_COLS), 0.02),
        'a_log': jnp.log(jax.random.uniform(ks[23], (DEPTH, 2, N_SSM_HEADS), F32, 1.0, 16.0)),
        'dt_bias': dt0 + jnp.log(-jnp.expm1(-dt0)),
        'd_skip': 1.0 + nrm(ks[24], (DEPTH, N_SSM_HEADS), 0.1),
        'g_ssm_norm': 1.0 + nrm(ks[25], (DEPTH, D_INNER), 0.02),
        'w_out': nrm(ks[26], (DEPTH, D_MODEL, D_MODEL), D_MODEL ** -0.5),
        'w_up': nrm(ks[27], (DEPTH, D_MODEL, D_FF), D_MODEL ** -0.5),
        'w_down': nrm(ks[28], (DEPTH, D_FF, D_MODEL), D_FF ** -0.5),
    }


def reference(x_prompt, x_sample, c, cache_k, cache_v, state_ssm_fwd, state_ssm_bwd, c_ctx,
              w_ada, b_ada, g_mix_pre, g_mix_post, g_mlp_pre, g_mlp_post, w_in,
              lambda_q1, lambda_k1, lambda_q2, lambda_k2, g_subln, conv_w, conv_b,
              a_log, dt_bias, d_skip, g_ssm_norm, w_out, w_up, w_down):
    xp = x_prompt
    xs = x_sample
    bp = xp.shape[0]
    bd = xs.shape[0]
    sshape = (N_GROUPS, HEADS_PER_GROUP, SSM_HD, D_STATE)
    new_k, new_v, new_sf, new_sb = [], [], [], []
    for l in range(DEPTH):
        p = dict(w_ada=w_ada[l], b_ada=b_ada[l], g_mix_pre=g_mix_pre[l], g_mix_post=g_mix_post[l],
                 g_mlp_pre=g_mlp_pre[l], g_mlp_post=g_mlp_post[l], w_in=w_in[l],
                 lq1=lambda_q1[l], lk1=lambda_k1[l], lq2=lambda_q2[l], lk2=lambda_k2[l],
                 g_subln=g_subln[l], conv_w=conv_w[l], conv_b=conv_b[l], a_log=a_log[l],
                 dt_bias=dt_bias[l], d_skip=d_skip[l], g_ssm_norm=g_ssm_norm[l],
                 w_out=w_out[l], w_up=w_up[l], w_down=w_down[l])
        zero = jnp.zeros((bp,) + sshape, F32)
        xp, (k_c, v_c, sf, sb) = trunk_layer(xp, c_ctx[None, :], p, l, None, None, zero, zero)
        new_k.append(k_c)
        new_v.append(v_c)
        new_sf.append(sf.reshape(bp, N_SSM_HEADS, SSM_HD, D_STATE).astype(xp.dtype))
        new_sb.append(sb.reshape(bp, N_SSM_HEADS, SSM_HD, D_STATE).astype(xp.dtype))
        xs, _ = trunk_layer(xs, c, p, l, cache_k[:, l], cache_v[:, l],
                            state_ssm_fwd[:, l].reshape((bd,) + sshape),
                            state_ssm_bwd[:, l].reshape((bd,) + sshape))
    return (xp, xs, jnp.stack(new_k, axis=1), jnp.stack(new_v, axis=1),
            jnp.stack(new_sf, axis=1), jnp.stack(new_sb, axis=1))
```

```cpp
#include <hip/hip_runtime.h>
#include <cstdio>

namespace pg8 {
#define PG8_LAS __attribute__((address_space(3)))
typedef unsigned short bf16_t;
typedef short bf16x8 __attribute__((ext_vector_type(8)));
typedef float f32x4 __attribute__((ext_vector_type(4)));
typedef unsigned u32x4 __attribute__((ext_vector_type(4)));
typedef int i32x4 __attribute__((ext_vector_type(4)));
constexpr int BM = 256, BK = 64, HALF = 128, HTB = HALF * BK * 2  , STAGE_BYTES = 8 * HTB, NXCD = 8, WGM = 8;

__host__ __device__ __forceinline__ int lds_byte(int r, int c) { const int st = (r >> 4) * 2 + (c >> 5), rr = r & 15, cc = c & 31, ob = rr * 64 + cc * 2; return st * 1024 + (ob ^ (((ob >> 9) & 1) << 5)); }
__host__ __device__ __forceinline__ void stage_rc(int b, int& R, int& C) { const int st = b / 1024, sb = b % 1024, swz = sb ^ (((sb >> 9) & 1) << 5); R = (st >> 1) * 16 + swz / 64; C = (st & 1) * 32 + (swz % 64) / 2; }
__host__ __device__ __forceinline__ int perm32(int rho) { const int n = rho >> 4, i = rho & 15; return 8 * (i >> 2) + 4 * n + (i & 3); }

struct Unit { int pm, pn; };
struct Gemm { const bf16_t* A; const bf16_t* Bt; int M, N, K; };

struct StaticOrder {
    int nM, nN, nwg, G, c;
    __host__ __device__ void init(int M, int N, int G_, int c_) { nM = M / BM; nN = N / BM; nwg = nM * nN; G = G_; c = c_; }
    __host__ __device__ bool next(int i, Unit& u) const {
        const long L = (long)i * G + c; if (L >= nwg) return false;
        int wgid = (int)L; { const int q = nwg / NXCD, r = nwg % NXCD, xcd = wgid % NXCD, off = wgid / NXCD; wgid = (xcd < r ? xcd * (q + 1) : r * (q + 1) + (xcd - r) * q) + off; }
        const int nig = WGM * nN, gid = wgid / nig, fm = gid * WGM, gsz = (nM - fm) < WGM ? (nM - fm) : WGM;
        u.pm = fm + ((wgid % nig) % gsz); u.pn = (wgid % nig) / gsz; return true;
    }
    __device__ __forceinline__ void a_ready(const Unit&) const {}
    __device__ __forceinline__ void done(const Unit&) const {}
};

__device__ __forceinline__ unsigned cvt_pk_bf16(float lo, float hi) { unsigned r; asm volatile("v_cvt_pk_bf16_f32 %0, %1, %2" : "=v"(r) : "v"(lo), "v"(hi)); return r; }
typedef float f32x2 __attribute__((ext_vector_type(2)));
__device__ __forceinline__ f32x2 gelu_pk(f32x2 v) {
    const f32x2 av = __builtin_elementwise_abs(v), d = av * 0.2316418882f + 1.0f;
    f32x2 t; t.x = __builtin_amdgcn_rcpf(d.x); t.y = __builtin_amdgcn_rcpf(d.y);
    f32x2 q = t * 0.5307027145f + (-0.7265760135f); q = q * t + 0.7107068705f; q = q * t + (-0.142248368f); q = q * t + 0.127414796f; q = q * t;
    const f32x2 s = (v * v) * (-0.72134752044f);
    f32x2 e; e.x = __builtin_amdgcn_exp2f(s.x); e.y = __builtin_amdgcn_exp2f(s.y);
    const f32x2 m = v * (q * e), r = v - m;
    f32x2 o; o.x = v.x < 0.f ? m.x : r.x; o.y = v.y < 0.f ? m.y : r.y; return o;
}

template <int ACT  > struct EpiBf16 {
    static constexpr bool PERM = true, AFTER_DRAIN = false; static_assert(ACT == 0 || ACT == 1, "EpiBf16: ACT is 0 (none) or 1 (gelu_pk)");
    bf16_t* O; int ldc; const float* bias; int split_cols; size_t split_stride; float scale0;
    __device__ __forceinline__ void operator()(const f32x4 (&acc)[2][2][4][2], const Unit& u, int wr, int wc, int fr, int fq) const {
        const int row0 = u.pm * BM + wr * 64 + fr; int colt = u.pn * BM; bf16_t* base = O;
        float sc = 1.f; if (split_cols) { const int t = colt / split_cols; base += (size_t)t * split_stride; colt -= t * split_cols; if (t == 0) sc = scale0; }
        const int col0 = colt + wc * 32 + 8 * fq, bcol0 = u.pn * BM + wc * 32 + 8 * fq;
        f32x4 bv[2][2];
#pragma unroll
        for (int bj = 0; bj < 2; ++bj)
#pragma unroll
            for (int n = 0; n < 2; ++n) bv[bj][n] = bias ? *(const f32x4*)(bias + bcol0 + bj * HALF + 4 * n) : (f32x4){0.f, 0.f, 0.f, 0.f};
#pragma unroll
        for (int ai = 0; ai < 2; ++ai)
#pragma unroll
            for (int m = 0; m < 4; ++m) { bf16_t* rowp = base + (size_t)(row0 + ai * HALF + m * 16) * ldc + col0;
#pragma unroll
                for (int bj = 0; bj < 2; ++bj) { f32x4 v0 = acc[ai][bj][m][0] + bv[bj][0], v1 = acc[ai][bj][m][1] + bv[bj][1];
                    if (ACT == 1) { f32x2 a = gelu_pk((f32x2){v0[0], v0[1]}), b = gelu_pk((f32x2){v0[2], v0[3]}), c = gelu_pk((f32x2){v1[0], v1[1]}), d = gelu_pk((f32x2){v1[2], v1[3]});
                        v0 = (f32x4){a.x, a.y, b.x, b.y}; v1 = (f32x4){c.x, c.y, d.x, d.y}; }
                    v0 = v0 * sc; v1 = v1 * sc; u32x4 w; w.x = cvt_pk_bf16(v0[0], v0[1]); w.y = cvt_pk_bf16(v0[2], v0[3]); w.z = cvt_pk_bf16(v1[0], v1[1]); w.w = cvt_pk_bf16(v1[2], v1[3]);
                    *(u32x4*)(rowp + bj * HALF) = w; } }
    }
};
template <class Epi, class Sched, bool ALIGN_EPI = false, bool SP2 = false>
__device__ __forceinline__ void gemm_phase(PG8_LAS unsigned char* lds, const Gemm g, const Sched& S, const Epi& E) {
    int tid = threadIdx.x; asm volatile("" : "+v"(tid));
    const int wid = __builtin_amdgcn_readfirstlane(tid >> 6), lane = tid & 63, wr = wid >> 2, wc = wid & 3, fr = lane & 15, fq = lane >> 4;
    const int K = g.K, nt = K / BK;
    unsigned voffA[2], voffB[2];
#pragma unroll
    for (int i = 0; i < 2; ++i) { int R, C; stage_rc(tid * 16 + i * 8192, R, C); const int Rb = Epi::PERM ? ((R & ~31) + perm32(R & 31)) : R;
        voffA[i] = (unsigned)(R * K + C) * 2u; voffB[i] = (unsigned)(Rb * K + C) * 2u; }
    const size_t kstep = (size_t)(BK * 2);
    const size_t hstep = (size_t)HALF * K * 2;
    const size_t tstep = 2 * hstep;
    const unsigned ldsw = (unsigned)wid * 1024u;
    const int aoff = lds_byte(wr * 64 + fr, fq * 8), boff = lds_byte(wc * 32 + fr, fq * 8);
#define PG8_SA(b, h) (((b) * 2 + (h)) * HTB)
#define PG8_SB(b, h) ((4 + (b) * 2 + (h)) * HTB)
#define PG8_STAGE(bufoff, gbase, voff) do { _Pragma("unroll") for (int _i = 0; _i < 2; ++_i) \
        __builtin_amdgcn_global_load_lds((const unsigned*)((const char*)(gbase) + (voff)[_i]), (PG8_LAS unsigned*)(lds + (bufoff) + ldsw + _i * 8192), 16, 0, 0); } while (0)
#define PG8_LDA(dst, b, h) do { _Pragma("unroll") for (int m = 0; m < 4; ++m) _Pragma("unroll") for (int k = 0; k < 2; ++k) dst[m][k] = *(const PG8_LAS bf16x8*)(lds + PG8_SA(b, h) + aoff + m * 2048 + k * 1024); } while (0)
#define PG8_LDB(dst, b, h) do { _Pragma("unroll") for (int n = 0; n < 2; ++n) _Pragma("unroll") for (int k = 0; k < 2; ++k) dst[n][k] = *(const PG8_LAS bf16x8*)(lds + PG8_SB(b, h) + boff + n * 2048 + k * 1024); } while (0)
#define PG8_MMA(ai, bj, At, Bt) do { __builtin_amdgcn_s_setprio(1); _Pragma("unroll") for (int m = 0; m < 4; ++m) _Pragma("unroll") for (int n = 0; n < 2; ++n) _Pragma("unroll") for (int k = 0; k < 2; ++k) \
        acc[ai][bj][m][n] = __builtin_amdgcn_mfma_f32_16x16x32_bf16(Bt[n][k], At[m][k], acc[ai][bj][m][n], 0, 0, 0); __builtin_amdgcn_s_setprio(0); } while (0)
#define PG8_WAIT_V(n) asm volatile("s_waitcnt vmcnt(" #n ")" ::: "memory")
#define PG8_WAIT_L(n) asm volatile("s_waitcnt lgkmcnt(" #n ")" ::: "memory")
#define PG8_BAR __builtin_amdgcn_s_barrier()
#define PG8_SCHED __builtin_amdgcn_sched_barrier(0)
    Unit cur, nxt; int ui = 0;
    if (!S.next(0, cur)) return;
    f32x4 acc[2][2][4][2];
#pragma unroll
    for (int a = 0; a < 2; ++a)
#pragma unroll
        for (int b = 0; b < 2; ++b)
#pragma unroll
            for (int m = 0; m < 4; ++m)
#pragma unroll
                for (int n = 0; n < 2; ++n) acc[a][b][m][n] = (f32x4){0.f, 0.f, 0.f, 0.f};
    bf16x8 At[4][2], B0[2][2], B1[2][2];
    const char* cA = (const char*)g.A + (size_t)cur.pm * tstep; const char* cB = (const char*)g.Bt + (size_t)cur.pn * tstep;
    S.a_ready(cur);
    if constexpr (SP2) {
        PG8_STAGE(PG8_SB(0, 0), cB, voffB); PG8_STAGE(PG8_SB(0, 1), cB + hstep, voffB); PG8_STAGE(PG8_SA(0, 0), cA, voffA); PG8_STAGE(PG8_SA(0, 1), cA + hstep, voffA);
        if (wr == 1) PG8_BAR;
        PG8_WAIT_V(2); PG8_BAR;
        PG8_STAGE(PG8_SB(1, 0), cB + kstep, voffB); PG8_STAGE(PG8_SA(1, 0), cA + kstep, voffA); PG8_STAGE(PG8_SB(1, 1), cB + hstep + kstep, voffB);
        PG8_WAIT_V(6); PG8_BAR;
    } else {
        PG8_STAGE(PG8_SB(0, 0), cB, voffB); PG8_STAGE(PG8_SA(0, 0), cA, voffA); PG8_STAGE(PG8_SB(0, 1), cB + hstep, voffB); PG8_STAGE(PG8_SA(0, 1), cA + hstep, voffA);
        if (wr == 1) PG8_BAR;
        PG8_WAIT_V(4); PG8_BAR;
        PG8_STAGE(PG8_SB(1, 0), cB + kstep, voffB); PG8_STAGE(PG8_SA(1, 0), cA + kstep, voffA); PG8_STAGE(PG8_SB(1, 1), cB + hstep + kstep, voffB);
        PG8_WAIT_V(6); PG8_BAR;
    }
    for (;;) {
        const bool has_next = S.next(ui + 1, nxt);
        const char* nA = has_next ? (const char*)g.A + (size_t)nxt.pm * tstep : cA; const char* nB = has_next ? (const char*)g.Bt + (size_t)nxt.pn * tstep : cB;
        for (int t = 0; t < nt; t += 2) {
            const bool last = (t == nt - 2);
            const char* a1 = cA + (size_t)(t + 1) * kstep;
            const char* a2 = last ? nA : cA + (size_t)(t + 2) * kstep; const char* b2 = last ? nB : cB + (size_t)(t + 2) * kstep;
            const char* a3 = a2 + kstep; const char* b3 = b2 + kstep;
            if (last && has_next) S.a_ready(nxt);
            if constexpr (SP2) {
            PG8_LDB(B0, 0, 0); PG8_LDB(B1, 0, 1); PG8_SCHED; PG8_LDA(At, 0, 0); PG8_STAGE(PG8_SA(1, 1), a1 + hstep, voffA);
            PG8_WAIT_V(8); PG8_WAIT_L(0); PG8_BAR; PG8_MMA(0, 0, At, B0); PG8_MMA(0, 1, At, B1); PG8_BAR; PG8_SCHED;
            PG8_LDA(At, 0, 1); PG8_STAGE(PG8_SB(0, 0), b2, voffB); PG8_STAGE(PG8_SB(0, 1), b2 + hstep, voffB); PG8_STAGE(PG8_SA(0, 0), a2, voffA);
            PG8_WAIT_V(8); PG8_WAIT_L(0); PG8_BAR; PG8_MMA(1, 0, At, B0); PG8_MMA(1, 1, At, B1); PG8_BAR; PG8_SCHED;
            PG8_LDB(B0, 1, 0); PG8_LDB(B1, 1, 1); PG8_SCHED; PG8_LDA(At, 1, 0); PG8_STAGE(PG8_SA(0, 1), a2 + hstep, voffA);
            PG8_WAIT_V(8); PG8_WAIT_L(0); PG8_BAR; PG8_MMA(0, 0, At, B0); PG8_MMA(0, 1, At, B1); PG8_BAR; PG8_SCHED;
            PG8_LDA(At, 1, 1); PG8_STAGE(PG8_SB(1, 0), b3, voffB); PG8_STAGE(PG8_SB(1, 1), b3 + hstep, voffB); PG8_STAGE(PG8_SA(1, 0), a3, voffA);
            PG8_WAIT_V(8); PG8_WAIT_L(0); PG8_BAR; PG8_MMA(1, 0, At, B0); PG8_MMA(1, 1, At, B1); PG8_BAR; PG8_SCHED;
            } else {
            PG8_LDB(B0, 0, 0); PG8_SCHED; PG8_LDA(At, 0, 0); PG8_STAGE(PG8_SA(1, 1), a1 + hstep, voffA);
            PG8_WAIT_L(8); PG8_BAR; PG8_WAIT_L(0); PG8_MMA(0, 0, At, B0); PG8_BAR; PG8_SCHED;
            PG8_LDB(B1, 0, 1); PG8_STAGE(PG8_SB(0, 0), b2, voffB);
            PG8_BAR; PG8_WAIT_L(0); PG8_MMA(0, 1, At, B1); PG8_BAR;
            PG8_LDA(At, 0, 1); PG8_STAGE(PG8_SA(0, 0), a2, voffA);
            PG8_BAR; PG8_WAIT_L(0); PG8_MMA(1, 0, At, B0); PG8_BAR; PG8_SCHED;
            PG8_STAGE(PG8_SB(0, 1), b2 + hstep, voffB);
            PG8_WAIT_V(6); PG8_BAR; PG8_MMA(1, 1, At, B1); PG8_BAR;
            PG8_LDB(B0, 1, 0); PG8_SCHED; PG8_LDA(At, 1, 0); PG8_STAGE(PG8_SA(0, 1), a2 + hstep, voffA);
            PG8_WAIT_L(8); PG8_BAR; PG8_WAIT_L(0); PG8_MMA(0, 0, At, B0); PG8_BAR; PG8_SCHED;
            PG8_LDB(B1, 1, 1); PG8_STAGE(PG8_SB(1, 0), b3, voffB);
            PG8_BAR; PG8_WAIT_L(0); PG8_MMA(0, 1, At, B1); PG8_BAR;
            PG8_LDA(At, 1, 1); PG8_STAGE(PG8_SA(1, 0), a3, voffA);
            PG8_BAR; PG8_WAIT_L(0); PG8_MMA(1, 0, At, B0); PG8_BAR; PG8_SCHED;
            PG8_STAGE(PG8_SB(1, 1), b3 + hstep, voffB);
            PG8_WAIT_V(6); PG8_BAR; PG8_MMA(1, 1, At, B1); PG8_BAR;
            }
        }
        if constexpr (ALIGN_EPI) { if (wr == 0) PG8_BAR; }
        if constexpr (!Epi::AFTER_DRAIN) { E(acc, cur, wr, wc, fr, fq); S.done(cur); }
        if (!has_next) break;
#pragma unroll
        for (int a = 0; a < 2; ++a)
#pragma unroll
            for (int b = 0; b < 2; ++b)
#pragma unroll
                for (int m = 0; m < 4; ++m)
#pragma unroll
                    for (int n = 0; n < 2; ++n) acc[a][b][m][n] = (f32x4){0.f, 0.f, 0.f, 0.f};
        cur = nxt; cA = nA; cB = nB; ++ui;
        if constexpr (ALIGN_EPI) { if (wr == 1) PG8_BAR; }
    }
    PG8_WAIT_V(0);
    if constexpr (!ALIGN_EPI) { if (wr == 0) PG8_BAR; }
    PG8_BAR;
    if constexpr (Epi::AFTER_DRAIN) { E.fused(acc, cur, wr, wc, fr, fq, lds, wid, lane); S.done(cur); }
#undef PG8_SA
#undef PG8_SB
#undef PG8_STAGE
#undef PG8_LDA
#undef PG8_LDB
#undef PG8_MMA
#undef PG8_WAIT_V
#undef PG8_WAIT_L
#undef PG8_BAR
#undef PG8_SCHED
}
template <class Epi, class Sched, bool ALIGN_EPI = false, bool SP2 = false>
__device__ __forceinline__ void gemm_phase_i8(PG8_LAS unsigned char* lds, const Gemm g, const Sched& S, const Epi& E) {
    int tid = threadIdx.x; asm volatile("" : "+v"(tid));
    const int wid = __builtin_amdgcn_readfirstlane(tid >> 6), lane = tid & 63, wr = wid >> 2, wc = wid & 3, fr = lane & 15, fq = lane >> 4;
    const int K = g.K, nt = K / BK;
    unsigned voffA[2], voffB[2];
#pragma unroll
    for (int i = 0; i < 2; ++i) { int R, C; stage_rc(tid * 16 + i * 8192, R, C); const int Rb = Epi::PERM ? ((R & ~31) + perm32(R & 31)) : R;
        voffA[i] = (unsigned)(R * K + C) * 2u; voffB[i] = (unsigned)(Rb * K + C) * 2u; }
    const size_t kstep = (size_t)(BK * 2);
    const size_t hstep = (size_t)HALF * K * 2;
    const size_t tstep = 2 * hstep;
    const unsigned ldsw = (unsigned)wid * 1024u;
    const int aoff = lds_byte(wr * 64 + fr, fq * 8), boff = lds_byte(wc * 32 + fr, fq * 8);
#define PG8_SA(b, h) (((b) * 2 + (h)) * HTB)
#define PG8_SB(b, h) ((4 + (b) * 2 + (h)) * HTB)
#define PG8_STAGE(bufoff, gbase, voff) do { _Pragma("unroll") for (int _i = 0; _i < 2; ++_i) \
        __builtin_amdgcn_global_load_lds((const unsigned*)((const char*)(gbase) + (voff)[_i]), (PG8_LAS unsigned*)(lds + (bufoff) + ldsw + _i * 8192), 16, 0, 0); } while (0)
#define PG8_LDA(dst, b, h) do { _Pragma("unroll") for (int m = 0; m < 4; ++m) _Pragma("unroll") for (int k = 0; k < 2; ++k) dst[m][k] = *(const PG8_LAS bf16x8*)(lds + PG8_SA(b, h) + aoff + m * 2048 + k * 1024); } while (0)
#define PG8_LDB(dst, b, h) do { _Pragma("unroll") for (int n = 0; n < 2; ++n) _Pragma("unroll") for (int k = 0; k < 2; ++k) dst[n][k] = *(const PG8_LAS bf16x8*)(lds + PG8_SB(b, h) + boff + n * 2048 + k * 1024); } while (0)
#define PG8_MMA(ai, bj, At, Bt) do { __builtin_amdgcn_s_setprio(1); _Pragma("unroll") for (int m = 0; m < 4; ++m) _Pragma("unroll") for (int n = 0; n < 2; ++n) _Pragma("unroll") for (int k = 0; k < 2; ++k) \
        acc[ai][bj][m][n] = __builtin_amdgcn_mfma_i32_16x16x64_i8(__builtin_bit_cast(i32x4, Bt[n][k]), __builtin_bit_cast(i32x4, At[m][k]), acc[ai][bj][m][n], 0, 0, 0); __builtin_amdgcn_s_setprio(0); } while (0)
#define PG8_WAIT_V(n) asm volatile("s_waitcnt vmcnt(" #n ")" ::: "memory")
#define PG8_WAIT_L(n) asm volatile("s_waitcnt lgkmcnt(" #n ")" ::: "memory")
#define PG8_BAR __builtin_amdgcn_s_barrier()
#define PG8_SCHED __builtin_amdgcn_sched_barrier(0)
    Unit cur, nxt; int ui = 0;
    if (!S.next(0, cur)) return;
    i32x4 acc[2][2][4][2];
#pragma unroll
    for (int a = 0; a < 2; ++a)
#pragma unroll
        for (int b = 0; b < 2; ++b)
#pragma unroll
            for (int m = 0; m < 4; ++m)
#pragma unroll
                for (int n = 0; n < 2; ++n) acc[a][b][m][n] = (i32x4){0, 0, 0, 0};
    bf16x8 At[4][2], B0[2][2], B1[2][2];
    const char* cA = (const char*)g.A + (size_t)cur.pm * tstep; const char* cB = (const char*)g.Bt + (size_t)cur.pn * tstep;
    S.a_ready(cur);
    if constexpr (SP2) {
        PG8_STAGE(PG8_SB(0, 0), cB, voffB); PG8_STAGE(PG8_SB(0, 1), cB + hstep, voffB); PG8_STAGE(PG8_SA(0, 0), cA, voffA); PG8_STAGE(PG8_SA(0, 1), cA + hstep, voffA);
        if (wr == 1) PG8_BAR;
        PG8_WAIT_V(2); PG8_BAR;
        PG8_STAGE(PG8_SB(1, 0), cB + kstep, voffB); PG8_STAGE(PG8_SA(1, 0), cA + kstep, voffA); PG8_STAGE(PG8_SB(1, 1), cB + hstep + kstep, voffB);
        PG8_WAIT_V(6); PG8_BAR;
    } else {
        PG8_STAGE(PG8_SB(0, 0), cB, voffB); PG8_STAGE(PG8_SA(0, 0), cA, voffA); PG8_STAGE(PG8_SB(0, 1), cB + hstep, voffB); PG8_STAGE(PG8_SA(0, 1), cA + hstep, voffA);
        if (wr == 1) PG8_BAR;
        PG8_WAIT_V(4); PG8_BAR;
        PG8_STAGE(PG8_SB(1, 0), cB + kstep, voffB); PG8_STAGE(PG8_SA(1, 0), cA + kstep, voffA); PG8_STAGE(PG8_SB(1, 1), cB + hstep + kstep, voffB);
        PG8_WAIT_V(6); PG8_BAR;
    }
    for (;;) {
        const bool has_next = S.next(ui + 1, nxt);
        const char* nA = has_next ? (const char*)g.A + (size_t)nxt.pm * tstep : cA; const char* nB = has_next ? (const char*)g.Bt + (size_t)nxt.pn * tstep : cB;
        for (int t = 0; t < nt; t += 2) {
            const bool last = (t == nt - 2);
            const char* a1 = cA + (size_t)(t + 1) * kstep;
            const char* a2 = last ? nA : cA + (size_t)(t + 2) * kstep; const char* b2 = last ? nB : cB + (size_t)(t + 2) * kstep;
            const char* a3 = a2 + kstep; const char* b3 = b2 + kstep;
            if (last && has_next) S.a_ready(nxt);
            if constexpr (SP2) {
            PG8_LDB(B0, 0, 0); PG8_LDB(B1, 0, 1); PG8_SCHED; PG8_LDA(At, 0, 0); PG8_STAGE(PG8_SA(1, 1), a1 + hstep, voffA);
            PG8_WAIT_V(8); PG8_WAIT_L(0); PG8_BAR; PG8_MMA(0, 0, At, B0); PG8_MMA(0, 1, At, B1); PG8_BAR; PG8_SCHED;
            PG8_LDA(At, 0, 1); PG8_STAGE(PG8_SB(0, 0), b2, voffB); PG8_STAGE(PG8_SB(0, 1), b2 + hstep, voffB); PG8_STAGE(PG8_SA(0, 0), a2, voffA);
            PG8_WAIT_V(8); PG8_WAIT_L(0); PG8_BAR; PG8_MMA(1, 0, At, B0); PG8_MMA(1, 1, At, B1); PG8_BAR; PG8_SCHED;
            PG8_LDB(B0, 1, 0); PG8_LDB(B1, 1, 1); PG8_SCHED; PG8_LDA(At, 1, 0); PG8_STAGE(PG8_SA(0, 1), a2 + hstep, voffA);
            PG8_WAIT_V(8); PG8_WAIT_L(0); PG8_BAR; PG8_MMA(0, 0, At, B0); PG8_MMA(0, 1, At, B1); PG8_BAR; PG8_SCHED;
            PG8_LDA(At, 1, 1); PG8_STAGE(PG8_SB(1, 0), b3, voffB); PG8_STAGE(PG8_SB(1, 1), b3 + hstep, voffB); PG8_STAGE(PG8_SA(1, 0), a3, voffA);
            PG8_WAIT_V(8); PG8_WAIT_L(0); PG8_BAR; PG8_MMA(1, 0, At, B0); PG8_MMA(1, 1, At, B1); PG8_BAR; PG8_SCHED;
            } else {
            PG8_LDB(B0, 0, 0); PG8_SCHED; PG8_LDA(At, 0, 0); PG8_STAGE(PG8_SA(1, 1), a1 + hstep, voffA);
            PG8_WAIT_L(8); PG8_BAR; PG8_WAIT_L(0); PG8_MMA(0, 0, At, B0); PG8_BAR; PG8_SCHED;
            PG8_LDB(B1, 0, 1); PG8_STAGE(PG8_SB(0, 0), b2, voffB);
            PG8_BAR; PG8_WAIT_L(0); PG8_MMA(0, 1, At, B1); PG8_BAR;
            PG8_LDA(At, 0, 1); PG8_STAGE(PG8_SA(0, 0), a2, voffA);
            PG8_BAR; PG8_WAIT_L(0); PG8_MMA(1, 0, At, B0); PG8_BAR; PG8_SCHED;
            PG8_STAGE(PG8_SB(0, 1), b2 + hstep, voffB);
            PG8_WAIT_V(6); PG8_BAR; PG8_MMA(1, 1, At, B1); PG8_BAR;
            PG8_LDB(B0, 1, 0); PG8_SCHED; PG8_LDA(At, 1, 0); PG8_STAGE(PG8_SA(0, 1), a2 + hstep, voffA);
            PG8_WAIT_L(8); PG8_BAR; PG8_WAIT_L(0); PG8_MMA(0, 0, At, B0); PG8_BAR; PG8_SCHED;
            PG8_LDB(B1, 1, 1); PG8_STAGE(PG8_SB(1, 0), b3, voffB);
            PG8_BAR; PG8_WAIT_L(0); PG8_MMA(0, 1, At, B1); PG8_BAR;
            PG8_LDA(At, 1, 1); PG8_STAGE(PG8_SA(1, 0), a3, voffA);
            PG8_BAR; PG8_WAIT_L(0); PG8_MMA(1, 0, At, B0); PG8_BAR; PG8_SCHED;
            PG8_STAGE(PG8_SB(1, 1), b3 + hstep, voffB);
            PG8_WAIT_V(6); PG8_BAR; PG8_MMA(1, 1, At, B1); PG8_BAR;
            }
        }
        if constexpr (ALIGN_EPI) { if (wr == 0) PG8_BAR; }
        if constexpr (!Epi::AFTER_DRAIN) { E(acc, cur, wr, wc, fr, fq); S.done(cur); }
        if (!has_next) break;
#pragma unroll
        for (int a = 0; a < 2; ++a)
#pragma unroll
            for (int b = 0; b < 2; ++b)
#pragma unroll
                for (int m = 0; m < 4; ++m)
#pragma unroll
                    for (int n = 0; n < 2; ++n) acc[a][b][m][n] = (i32x4){0, 0, 0, 0};
        cur = nxt; cA = nA; cB = nB; ++ui;
        if constexpr (ALIGN_EPI) { if (wr == 1) PG8_BAR; }
    }
    PG8_WAIT_V(0);
    if constexpr (!ALIGN_EPI) { if (wr == 0) PG8_BAR; }
    PG8_BAR;
    if constexpr (Epi::AFTER_DRAIN) { E.fused(acc, cur, wr, wc, fr, fq, lds, wid, lane); S.done(cur); }
#undef PG8_SA
#undef PG8_SB
#undef PG8_STAGE
#undef PG8_LDA
#undef PG8_LDB
#undef PG8_MMA
#undef PG8_WAIT_V
#undef PG8_WAIT_L
#undef PG8_BAR
#undef PG8_SCHED
}
}
namespace pg8 {
template <int ACT  > struct EpiBf {
    static constexpr bool PERM = true, AFTER_DRAIN = false;
    bf16_t* O; int ldc;
    __device__ __forceinline__ void operator()(const f32x4 (&acc)[2][2][4][2], const Unit& u, int wr, int wc, int fr, int fq) const {
        const int row0 = u.pm * BM + wr * 64 + fr, col0 = u.pn * BM + wc * 32 + 8 * fq;
#pragma unroll
        for (int ai = 0; ai < 2; ++ai)
#pragma unroll
            for (int m = 0; m < 4; ++m) { bf16_t* rowp = O + (size_t)(row0 + ai * HALF + m * 16) * ldc + col0;
#pragma unroll
                for (int bj = 0; bj < 2; ++bj) { f32x4 v0 = acc[ai][bj][m][0], v1 = acc[ai][bj][m][1];
                    if (ACT == 1) {
#pragma unroll
                        for (int j = 0; j < 4; ++j) { const float a = fmaxf(v0[j], 0.f), b = fmaxf(v1[j], 0.f); v0[j] = a * a; v1[j] = b * b; } }
                    u32x4 w; w.x = cvt_pk_bf16(v0[0], v0[1]); w.y = cvt_pk_bf16(v0[2], v0[3]); w.z = cvt_pk_bf16(v1[0], v1[1]); w.w = cvt_pk_bf16(v1[2], v1[3]);
                    *(u32x4*)(rowp + bj * HALF) = w; } }
    }
};
struct EpiUp {
    static constexpr bool PERM = true, AFTER_DRAIN = false;
    bf16_t* O; int ldc; unsigned* rmax;
    __device__ __forceinline__ void operator()(const f32x4 (&acc)[2][2][4][2], const Unit& u, int wr, int wc, int fr, int fq) const {
        const int row0 = u.pm * BM + wr * 64 + fr, col0 = u.pn * BM + wc * 32 + 8 * fq;
#pragma unroll
        for (int ai = 0; ai < 2; ++ai)
#pragma unroll
            for (int m = 0; m < 4; ++m) { const int row = row0 + ai * HALF + m * 16; bf16_t* rowp = O + (size_t)row * ldc + col0; float mx = 0.f;
#pragma unroll
                for (int bj = 0; bj < 2; ++bj) { f32x4 v0 = acc[ai][bj][m][0], v1 = acc[ai][bj][m][1];
#pragma unroll
                    for (int j = 0; j < 4; ++j) { const float a = fmaxf(v0[j], 0.f), b = fmaxf(v1[j], 0.f); v0[j] = a * a; v1[j] = b * b; mx = fmaxf(mx, fmaxf(v0[j], v1[j])); }
                    u32x4 w; w.x = cvt_pk_bf16(v0[0], v0[1]); w.y = cvt_pk_bf16(v0[2], v0[3]); w.z = cvt_pk_bf16(v1[0], v1[1]); w.w = cvt_pk_bf16(v1[2], v1[3]);
                    *(u32x4*)(rowp + bj * HALF) = w; }
                mx = fmaxf(mx, __shfl_xor(mx, 16)); mx = fmaxf(mx, __shfl_xor(mx, 32));
                if (fq == 0) __hip_atomic_fetch_max(rmax + row, __float_as_uint(mx), __ATOMIC_RELAXED, __HIP_MEMORY_SCOPE_AGENT); }
    }
};
struct EpiMixI8 {
    static constexpr bool PERM = true, AFTER_DRAIN = false;
    bf16_t* O; int ldc; const float* sA; const float* sB;
    __device__ __forceinline__ void operator()(const i32x4 (&acc)[2][2][4][2], const Unit& u, int wr, int wc, int fr, int fq) const {
        const int row0 = u.pm * BM + wr * 64 + fr, col0 = u.pn * BM + wc * 32 + 8 * fq;
        f32x4 sb[2][2];
#pragma unroll
        for (int bj = 0; bj < 2; ++bj)
#pragma unroll
            for (int n = 0; n < 2; ++n) sb[bj][n] = *(const f32x4*)(sB + col0 + bj * HALF + 4 * n);
        float sav[2][4];
#pragma unroll
        for (int ai = 0; ai < 2; ++ai)
#pragma unroll
            for (int m = 0; m < 4; ++m) sav[ai][m] = sA[row0 + ai * HALF + m * 16];
        asm volatile("" ::: "memory");
#pragma unroll
        for (int ai = 0; ai < 2; ++ai)
#pragma unroll
            for (int m = 0; m < 4; ++m) { const int row = row0 + ai * HALF + m * 16; bf16_t* rowp = O + (size_t)row * ldc + col0; const float sa = sav[ai][m];
#pragma unroll
                for (int bj = 0; bj < 2; ++bj) { f32x4 v0, v1;
#pragma unroll
                    for (int j = 0; j < 4; ++j) { v0[j] = (float)acc[ai][bj][m][0][j] * sb[bj][0][j] * sa; v1[j] = (float)acc[ai][bj][m][1][j] * sb[bj][1][j] * sa; }
                    u32x4 w; w.x = cvt_pk_bf16(v0[0], v0[1]); w.y = cvt_pk_bf16(v0[2], v0[3]); w.z = cvt_pk_bf16(v1[0], v1[1]); w.w = cvt_pk_bf16(v1[2], v1[3]);
                    *(u32x4*)(rowp + bj * HALF) = w; } }
    }
};
struct EpiUpI8 {
    static constexpr bool PERM = true, AFTER_DRAIN = false;
    bf16_t* O; int ldc; unsigned* rmax; const float* sA; const float* sB;
    __device__ __forceinline__ void operator()(const i32x4 (&acc)[2][2][4][2], const Unit& u, int wr, int wc, int fr, int fq) const {
        const int row0 = u.pm * BM + wr * 64 + fr, col0 = u.pn * BM + wc * 32 + 8 * fq;
        f32x4 sb[2][2];
#pragma unroll
        for (int bj = 0; bj < 2; ++bj)
#pragma unroll
            for (int n = 0; n < 2; ++n) sb[bj][n] = *(const f32x4*)(sB + col0 + bj * HALF + 4 * n);
        float sav[2][4];
#pragma unroll
        for (int ai = 0; ai < 2; ++ai)
#pragma unroll
            for (int m = 0; m < 4; ++m) sav[ai][m] = sA[row0 + ai * HALF + m * 16];
        asm volatile("" ::: "memory");
#pragma unroll
        for (int ai = 0; ai < 2; ++ai)
#pragma unroll
            for (int m = 0; m < 4; ++m) { const int row = row0 + ai * HALF + m * 16; bf16_t* rowp = O + (size_t)row * ldc + col0; const float sa = sav[ai][m]; float mx = 0.f;
#pragma unroll
                for (int bj = 0; bj < 2; ++bj) { f32x4 v0, v1;
#pragma unroll
                    for (int j = 0; j < 4; ++j) { const float a = fmaxf((float)acc[ai][bj][m][0][j] * sb[bj][0][j] * sa, 0.f), b = fmaxf((float)acc[ai][bj][m][1][j] * sb[bj][1][j] * sa, 0.f);
                        v0[j] = a * a; v1[j] = b * b; mx = fmaxf(mx, fmaxf(v0[j], v1[j])); }
                    u32x4 w; w.x = cvt_pk_bf16(v0[0], v0[1]); w.y = cvt_pk_bf16(v0[2], v0[3]); w.z = cvt_pk_bf16(v1[0], v1[1]); w.w = cvt_pk_bf16(v1[2], v1[3]);
                    *(u32x4*)(rowp + bj * HALF) = w; }
                mx = fmaxf(mx, __shfl_xor(mx, 16)); mx = fmaxf(mx, __shfl_xor(mx, 32));
                if (fq == 0) __hip_atomic_fetch_max(rmax + row, __float_as_uint(mx), __ATOMIC_RELAXED, __HIP_MEMORY_SCOPE_AGENT); }
    }
};
struct EpiUpI8L {
    static constexpr bool PERM = true, AFTER_DRAIN = false;
    unsigned char* Oq; int ldc; float* LM; const float* sA; const float* sB;
    __device__ __forceinline__ void operator()(const i32x4 (&acc)[2][2][4][2], const Unit& u, int wr, int wc, int fr, int fq) const {
        const int row0 = u.pm * BM + wr * 64 + fr, col0 = u.pn * BM + wc * 32 + 8 * fq, nlb = ldc >> 6;
        f32x4 sb[2][2];
#pragma unroll
        for (int bj = 0; bj < 2; ++bj)
#pragma unroll
            for (int n = 0; n < 2; ++n) sb[bj][n] = *(const f32x4*)(sB + col0 + bj * HALF + 4 * n);
        float sav[2][4];
#pragma unroll
        for (int ai = 0; ai < 2; ++ai)
#pragma unroll
            for (int m = 0; m < 4; ++m) sav[ai][m] = sA[row0 + ai * HALF + m * 16];
        asm volatile("" ::: "memory");
#pragma unroll
        for (int ai = 0; ai < 2; ++ai)
#pragma unroll
            for (int m = 0; m < 4; ++m) { const int row = row0 + ai * HALF + m * 16; const float sa = sav[ai][m]; float uu[2][8]; float mx = 0.f;
#pragma unroll
                for (int bj = 0; bj < 2; ++bj)
#pragma unroll
                    for (int j = 0; j < 4; ++j) { const int ia = acc[ai][bj][m][0][j], ib = acc[ai][bj][m][1][j];
                        const float a = (float)(ia > 0 ? ia : 0) * sb[bj][0][j], b = (float)(ib > 0 ? ib : 0) * sb[bj][1][j];
                        uu[bj][j] = a * a; uu[bj][4 + j] = b * b; mx = fmaxf(mx, fmaxf(uu[bj][j], uu[bj][4 + j])); }
                mx = fmaxf(mx, __shfl_xor(mx, 16)); mx = fmaxf(mx, __shfl_xor(mx, 32));
                const float inv = mx > 0.f ? 255.f / mx : 0.f;
                unsigned char* rowp = Oq + (size_t)row * ldc + col0;
#pragma unroll
                for (int bj = 0; bj < 2; ++bj) { unsigned w[2];
#pragma unroll
                    for (int h2 = 0; h2 < 2; ++h2) { unsigned t[4];
#pragma unroll
                        for (int e = 0; e < 4; ++e) t[e] = __float_as_uint(fmaf(uu[bj][4 * h2 + e], inv, 12582784.f));
                        w[h2] = __builtin_amdgcn_perm(__builtin_amdgcn_perm(t[3], t[2], 0x0c0c0400u), __builtin_amdgcn_perm(t[1], t[0], 0x0c0c0400u), 0x05040100u); }
                    typedef unsigned u32x2 __attribute__((ext_vector_type(2)));
                    *(u32x2*)(rowp + bj * HALF) = (u32x2){w[0], w[1]}; }
                if (fq == 0) LM[(size_t)row * nlb + u.pn * 4 + wc] = mx * sa * sa; }
    }
};
struct EpiDownI8 {
    static constexpr bool PERM = true, AFTER_DRAIN = false;
    bf16_t* O; int ldc; const float* sA; const float* sB; const int* CS;
    __device__ __forceinline__ void operator()(const i32x4 (&acc)[2][2][4][2], const Unit& u, int wr, int wc, int fr, int fq) const {
        const int row0 = u.pm * BM + wr * 64 + fr, col0 = u.pn * BM + wc * 32 + 8 * fq;
        f32x4 sb[2][2]; i32x4 cs[2][2];
#pragma unroll
        for (int bj = 0; bj < 2; ++bj)
#pragma unroll
            for (int n = 0; n < 2; ++n) { sb[bj][n] = *(const f32x4*)(sB + col0 + bj * HALF + 4 * n); cs[bj][n] = *(const i32x4*)(CS + col0 + bj * HALF + 4 * n) * 128; }
        float sav[2][4];
#pragma unroll
        for (int ai = 0; ai < 2; ++ai)
#pragma unroll
            for (int m = 0; m < 4; ++m) sav[ai][m] = sA[row0 + ai * HALF + m * 16];
        asm volatile("" ::: "memory");
#pragma unroll
        for (int ai = 0; ai < 2; ++ai)
#pragma unroll
            for (int m = 0; m < 4; ++m) { const int row = row0 + ai * HALF + m * 16; const float sa = sav[ai][m]; bf16_t* rowp = O + (size_t)row * ldc + col0;
#pragma unroll
                for (int bj = 0; bj < 2; ++bj) { const i32x4 a0 = acc[ai][bj][m][0] + cs[bj][0], a1 = acc[ai][bj][m][1] + cs[bj][1];
                    f32x4 v0, v1;
#pragma unroll
                    for (int j = 0; j < 4; ++j) { v0[j] = (float)a0[j] * sb[bj][0][j] * sa; v1[j] = (float)a1[j] * sb[bj][1][j] * sa; }
                    u32x4 w; w.x = cvt_pk_bf16(v0[0], v0[1]); w.y = cvt_pk_bf16(v0[2], v0[3]); w.z = cvt_pk_bf16(v1[0], v1[1]); w.w = cvt_pk_bf16(v1[2], v1[3]);
                    *(u32x4*)(rowp + bj * HALF) = w; } }
    }
};
struct EpiIn {
    static constexpr bool PERM = true, AFTER_DRAIN = false;
    bf16_t *KP, *KS, *VP, *VS, *XR; float *DT, *outK, *outV; int pn0, row0;
    __device__ __forceinline__ void operator()(const f32x4 (&acc)[2][2][4][2], const Unit& u, int wr, int wc, int fr, int fq) const {
        const int pn = u.pn + pn0, rl = wr * 64 + fr, cl = wc * 32 + 8 * fq;
        const int rowt = row0 + u.pm * BM;
        bf16_t* bdst = nullptr; float* fdst = nullptr; int ldb = 2048; size_t brow = (size_t)rowt; int colb = 0;
        if (pn < 16) {
            const bool isv = pn >= 8; colb = (pn - (isv ? 8 : 0)) * 256;
            if (rowt < 8192) { bdst = isv ? VP : KP; fdst = isv ? outV : outK; }
            else { const int sr = rowt - 8192, b = sr >> 12, t = sr & 4095; bdst = isv ? VS : KS; brow = (size_t)b * 4608 + 512 + t; }
        }
        else if (pn < 28) { bdst = XR; ldb = 3072; colb = (pn - 16) * 256; }
        if (pn < 28) {
#pragma unroll
            for (int ai = 0; ai < 2; ++ai)
#pragma unroll
                for (int m = 0; m < 4; ++m) { const int r = rl + ai * HALF + m * 16;
#pragma unroll
                    for (int bj = 0; bj < 2; ++bj) { const f32x4 v0 = acc[ai][bj][m][0], v1 = acc[ai][bj][m][1]; const int c = colb + cl + bj * HALF;
                        u32x4 w; w.x = cvt_pk_bf16(v0[0], v0[1]); w.y = cvt_pk_bf16(v0[2], v0[3]); w.z = cvt_pk_bf16(v1[0], v1[1]); w.w = cvt_pk_bf16(v1[2], v1[3]);
                        *(u32x4*)(bdst + (brow + r) * ldb + c) = w;
                        if (fdst) { float* fp = fdst + (size_t)(rowt + r) * 2048 + c; *(f32x4*)fp = v0; *(f32x4*)(fp + 4) = v1; } } }
        } else {
            if (cl < 64) {
#pragma unroll
                for (int ai = 0; ai < 2; ++ai)
#pragma unroll
                    for (int m = 0; m < 4; ++m) { const int r = rowt + rl + ai * HALF + m * 16; float* fp = DT + (size_t)r * 64 + cl;
                        *(f32x4*)fp = acc[ai][0][m][0]; *(f32x4*)(fp + 4) = acc[ai][0][m][1]; }
            }
        }
    }
};
struct EpiQZ {
    static constexpr bool PERM = true, AFTER_DRAIN = false;
    bf16_t *Q, *Z; const float* sA; const float* sB;
    __device__ __forceinline__ void operator()(const i32x4 (&acc)[2][2][4][2], const Unit& u, int wr, int wc, int fr, int fq) const {
        const int row0 = u.pm * BM + wr * 64 + fr, cl = wc * 32 + 8 * fq, colv = u.pn * BM + cl;
        bf16_t* dst = u.pn < 8 ? Q : Z; const int cold = (u.pn & 7) * BM + cl;
        f32x4 sb[2][2];
#pragma unroll
        for (int bj = 0; bj < 2; ++bj)
#pragma unroll
            for (int n = 0; n < 2; ++n) sb[bj][n] = *(const f32x4*)(sB + colv + bj * HALF + 4 * n);
        float sav[2][4];
#pragma unroll
        for (int ai = 0; ai < 2; ++ai)
#pragma unroll
            for (int m = 0; m < 4; ++m) sav[ai][m] = sA[row0 + ai * HALF + m * 16];
        asm volatile("" ::: "memory");
#pragma unroll
        for (int ai = 0; ai < 2; ++ai)
#pragma unroll
            for (int m = 0; m < 4; ++m) { const int row = row0 + ai * HALF + m * 16; bf16_t* rowp = dst + (size_t)row * 2048 + cold; const float sa = sav[ai][m];
#pragma unroll
                for (int bj = 0; bj < 2; ++bj) { f32x4 v0, v1;
#pragma unroll
                    for (int j = 0; j < 4; ++j) { v0[j] = (float)acc[ai][bj][m][0][j] * sb[bj][0][j] * sa; v1[j] = (float)acc[ai][bj][m][1][j] * sb[bj][1][j] * sa; }
                    u32x4 w; w.x = cvt_pk_bf16(v0[0], v0[1]); w.y = cvt_pk_bf16(v0[2], v0[3]); w.z = cvt_pk_bf16(v1[0], v1[1]); w.w = cvt_pk_bf16(v1[2], v1[3]);
                    *(u32x4*)(rowp + bj * HALF) = w; } }
    }
};
struct EpiKVs {
    static constexpr bool PERM = true, AFTER_DRAIN = false;
    bf16_t *KS, *VS; const float* sA; const float* sB;
    __device__ __forceinline__ void operator()(const i32x4 (&acc)[2][2][4][2], const Unit& u, int wr, int wc, int fr, int fq) const {
        const int rl = wr * 64 + fr, cl = wc * 32 + 8 * fq, colv = u.pn * BM + cl, sr = u.pm * BM, b = sr >> 12, t = sr & 4095;
        bf16_t* dst = (u.pn < 8 ? KS : VS) + ((size_t)b * 4608 + 512 + t) * 2048 + (u.pn & 7) * BM + cl;
        f32x4 sb[2][2];
#pragma unroll
        for (int bj = 0; bj < 2; ++bj)
#pragma unroll
            for (int n = 0; n < 2; ++n) sb[bj][n] = *(const f32x4*)(sB + colv + bj * HALF + 4 * n);
        float sav[2][4];
#pragma unroll
        for (int ai = 0; ai < 2; ++ai)
#pragma unroll
            for (int m = 0; m < 4; ++m) sav[ai][m] = sA[sr + rl + ai * HALF + m * 16];
        asm volatile("" ::: "memory");
#pragma unroll
        for (int ai = 0; ai < 2; ++ai)
#pragma unroll
            for (int m = 0; m < 4; ++m) { const int r = rl + ai * HALF + m * 16; bf16_t* rowp = dst + (size_t)r * 2048; const float sa = sav[ai][m];
#pragma unroll
                for (int bj = 0; bj < 2; ++bj) { f32x4 v0, v1;
#pragma unroll
                    for (int j = 0; j < 4; ++j) { v0[j] = (float)acc[ai][bj][m][0][j] * sb[bj][0][j] * sa; v1[j] = (float)acc[ai][bj][m][1][j] * sb[bj][1][j] * sa; }
                    u32x4 w; w.x = cvt_pk_bf16(v0[0], v0[1]); w.y = cvt_pk_bf16(v0[2], v0[3]); w.z = cvt_pk_bf16(v1[0], v1[1]); w.w = cvt_pk_bf16(v1[2], v1[3]);
                    *(u32x4*)(rowp + bj * HALF) = w; } }
    }
};
struct EpiKVa {
    static constexpr bool PERM = true, AFTER_DRAIN = false;
    bf16_t *KP, *KS, *VP, *VS; float *outK, *outV; const float* sA; const float* sB;
    __device__ __forceinline__ void operator()(const i32x4 (&acc)[2][2][4][2], const Unit& u, int wr, int wc, int fr, int fq) const {
        const int rl = wr * 64 + fr, cl = wc * 32 + 8 * fq, colv = u.pn * BM + cl, rowt = u.pm * BM, colb = (u.pn & 7) * BM + cl; const bool isv = u.pn >= 8;
        bf16_t* dst; float* fdst = nullptr;
        if (rowt < 8192) { dst = (isv ? VP : KP) + (size_t)rowt * 2048 + colb; fdst = (isv ? outV : outK) + (size_t)rowt * 2048 + colb; }
        else { const int sr = rowt - 8192, b = sr >> 12, t = sr & 4095; dst = (isv ? VS : KS) + ((size_t)b * 4608 + 512 + t) * 2048 + colb; }
        f32x4 sb[2][2];
#pragma unroll
        for (int bj = 0; bj < 2; ++bj)
#pragma unroll
            for (int n = 0; n < 2; ++n) sb[bj][n] = *(const f32x4*)(sB + colv + bj * HALF + 4 * n);
        float sav[2][4];
#pragma unroll
        for (int ai = 0; ai < 2; ++ai)
#pragma unroll
            for (int m = 0; m < 4; ++m) sav[ai][m] = sA[rowt + rl + ai * HALF + m * 16];
        asm volatile("" ::: "memory");
#pragma unroll
        for (int ai = 0; ai < 2; ++ai)
#pragma unroll
            for (int m = 0; m < 4; ++m) { const int r = rl + ai * HALF + m * 16; bf16_t* rowp = dst + (size_t)r * 2048; const float sa = sav[ai][m];
#pragma unroll
                for (int bj = 0; bj < 2; ++bj) { f32x4 v0, v1;
#pragma unroll
                    for (int j = 0; j < 4; ++j) { v0[j] = (float)acc[ai][bj][m][0][j] * sb[bj][0][j] * sa; v1[j] = (float)acc[ai][bj][m][1][j] * sb[bj][1][j] * sa; }
                    u32x4 w; w.x = cvt_pk_bf16(v0[0], v0[1]); w.y = cvt_pk_bf16(v0[2], v0[3]); w.z = cvt_pk_bf16(v1[0], v1[1]); w.w = cvt_pk_bf16(v1[2], v1[3]);
                    *(u32x4*)(rowp + bj * HALF) = w;
                    if (fdst) { float* fp = fdst + (size_t)r * 2048 + bj * HALF; *(f32x4*)fp = v0; *(f32x4*)(fp + 4) = v1; } } }
    }
};
struct EpiXs {
    static constexpr bool PERM = true, AFTER_DRAIN = false;
    bf16_t* XR; const float* sA; const float* sB;
    __device__ __forceinline__ void operator()(const i32x4 (&acc)[2][2][4][2], const Unit& u, int wr, int wc, int fr, int fq) const {
        const int row0 = u.pm * BM + wr * 64 + fr, col0 = u.pn * BM + wc * 32 + 8 * fq;
        f32x4 sb[2][2];
#pragma unroll
        for (int bj = 0; bj < 2; ++bj)
#pragma unroll
            for (int n = 0; n < 2; ++n) sb[bj][n] = *(const f32x4*)(sB + col0 + bj * HALF + 4 * n);
        float sav[2][4];
#pragma unroll
        for (int ai = 0; ai < 2; ++ai)
#pragma unroll
            for (int m = 0; m < 4; ++m) sav[ai][m] = sA[row0 + ai * HALF + m * 16];
        asm volatile("" ::: "memory");
#pragma unroll
        for (int ai = 0; ai < 2; ++ai)
#pragma unroll
            for (int m = 0; m < 4; ++m) { const int row = row0 + ai * HALF + m * 16; bf16_t* rowp = XR + (size_t)row * 3072 + col0; const float sa = sav[ai][m];
#pragma unroll
                for (int bj = 0; bj < 2; ++bj) { f32x4 v0, v1;
#pragma unroll
                    for (int j = 0; j < 4; ++j) { v0[j] = (float)acc[ai][bj][m][0][j] * sb[bj][0][j] * sa; v1[j] = (float)acc[ai][bj][m][1][j] * sb[bj][1][j] * sa; }
                    u32x4 w; w.x = cvt_pk_bf16(v0[0], v0[1]); w.y = cvt_pk_bf16(v0[2], v0[3]); w.z = cvt_pk_bf16(v1[0], v1[1]); w.w = cvt_pk_bf16(v1[2], v1[3]);
                    *(u32x4*)(rowp + bj * HALF) = w; } }
    }
};
}

namespace att {
typedef unsigned short bf16;
constexpr int   D = 128, NW = 8, QBLK = 32, KVBLK = 64;
constexpr float SCALE = 0.088388347648318440f;
constexpr float THR = 8.f;
constexpr int SDEPTH = 2;
constexpr int LDQ = 2048, LDK = 2048;
constexpr size_t SHM_V = KVBLK * D * 2, SHM_K = KVBLK * D * 2, SHM_ATTN = 2 * SHM_V + 2 * SHM_K + NW * 64 * 4;
using bf16x8 = __attribute__((ext_vector_type(8))) short;
using s16x4  = __attribute__((ext_vector_type(4))) short;
using f32x16 = __attribute__((ext_vector_type(16))) float;
using u32x4  = __attribute__((ext_vector_type(4))) unsigned;
using f32x4v = __attribute__((ext_vector_type(4))) float;
#define KSWZ(row, colB) ((row) * 256 + ((colB) ^ (((row) & 7) << 4)))
#define SBAR() __builtin_amdgcn_sched_barrier(0)
__device__ __forceinline__ int crow(int r, int hi) { return (r & 3) + 8 * (r >> 2) + 4 * hi; }
__device__ __forceinline__ unsigned cvtpk(float lo, float hi) {
  unsigned r; asm volatile("v_cvt_pk_bf16_f32 %0, %1, %2" : "=v"(r) : "v"(lo), "v"(hi)); return r;
}
__device__ __forceinline__ bf16x8 ld8(const bf16* p) { return *reinterpret_cast<const bf16x8*>(p); }

__device__ __forceinline__ void partialSM(f32x16& p0, f32x16& p1, float& m_reg, float& mn, float& alpha) {
  constexpr float C = SCALE * 1.4426950408889634f;
  float pmax = p0[0]; for (int r = 1; r < 16; ++r) pmax = fmaxf(pmax, p0[r]); for (int r = 0; r < 16; ++r) pmax = fmaxf(pmax, p1[r]);
  { auto rr = __builtin_amdgcn_permlane32_swap(__float_as_uint(pmax), __float_as_uint(pmax), false, false);
    pmax = fmaxf(__uint_as_float(rr[0]), __uint_as_float(rr[1])); }
  if (__builtin_expect(__all(pmax - m_reg <= THR / SCALE), 1)) { mn = m_reg; alpha = 1.f; }
  else { mn = fmaxf(m_reg, pmax); alpha = __builtin_amdgcn_exp2f((m_reg - mn) * C); m_reg = mn; }
  float mnC = -mn * C;
  for (int r = 0; r < 16; ++r) p0[r] = fmaf(p0[r], C, mnC); for (int r = 0; r < 16; ++r) p1[r] = fmaf(p1[r], C, mnC);
  for (int r = 0; r < 16; ++r) p0[r] = __builtin_amdgcn_exp2f(p0[r]);
}
__device__ __forceinline__ void finishSM(f32x16& p0, f32x16& p1, float alpha, float& l_reg, bf16x8& pa0, bf16x8& pa1, bf16x8& pa2, bf16x8& pa3) {
  for (int r = 0; r < 16; ++r) p1[r] = __builtin_amdgcn_exp2f(p1[r]);
  float ps = 0; for (int r = 0; r < 16; ++r) ps += p0[r]; for (int r = 0; r < 16; ++r) ps += p1[r];
  { auto rr = __builtin_amdgcn_permlane32_swap(__float_as_uint(ps), __float_as_uint(ps), false, false);
    ps = __uint_as_float(rr[0]) + __uint_as_float(rr[1]); }
  l_reg = l_reg * alpha + ps;
#define PK4(P, BASE, OUT) do { unsigned a0 = cvtpk(P[BASE + 0], P[BASE + 1]), a1 = cvtpk(P[BASE + 2], P[BASE + 3]);   \
    unsigned b0 = cvtpk(P[BASE + 4], P[BASE + 5]), b1 = cvtpk(P[BASE + 6], P[BASE + 7]);                              \
    auto r0 = __builtin_amdgcn_permlane32_swap(a0, b0, false, false); auto r1 = __builtin_amdgcn_permlane32_swap(a1, b1, false, false); \
    u32x4 w = {r0[0], r1[0], r0[1], r1[1]}; OUT = *reinterpret_cast<bf16x8*>(&w); } while (0)
  PK4(p0, 0, pa0); PK4(p0, 8, pa1); PK4(p1, 0, pa2); PK4(p1, 8, pa3);
#undef PK4
}
__device__ __forceinline__ void qkt(f32x16& p0, f32x16& p1, const bf16* Ks, const bf16x8* qr, int r32, int hi) {
  p0 = f32x16{}; p1 = f32x16{};
  for (int d0 = 0; d0 < 8; ++d0) { int cb = (d0 * 16 + hi * 8) * 2;
    bf16x8 b0 = *reinterpret_cast<const bf16x8*>((const char*)Ks + KSWZ(r32, cb));
    bf16x8 b1 = *reinterpret_cast<const bf16x8*>((const char*)Ks + KSWZ(32 + r32, cb));
    p0 = __builtin_amdgcn_mfma_f32_32x32x16_bf16(b0, qr[d0], p0, 0, 0, 0);
    p1 = __builtin_amdgcn_mfma_f32_32x32x16_bf16(b1, qr[d0], p1, 0, 0, 0); }
}
__device__ __forceinline__ int v_st(int k, int c) { const int kk = (k & ~0xC) | ((k & 4) << 1) | ((k & 8) >> 1); return ((kk >> 3) * 4 + (c >> 5)) * 512 + ((kk & 7) * 32 + (c & 31)) * 2; }
__device__ __forceinline__ int v_rd_base(int lane) { return ((lane & 3) << 3) | (((lane >> 2) & 3) << 6) | (((lane >> 4) & 1) << 5) | (((lane >> 5) & 1) << 8); }
constexpr int v_rd_off(int d0, int ks, int half) { return d0 * 512 + ks * 4096 + half * 2048; }
template <int OFF> __device__ __forceinline__ s16x4 tr_read(int vb) {
  s16x4 r; asm volatile("ds_read_b64_tr_b16 %0, %1 offset:%2" : "=&v"(r) : "v"(vb), "i"(OFF) : "memory"); return r;
}
template <int D0> __device__ __forceinline__ void pv_one(f32x16& od, int vb, bf16x8 pa0, bf16x8 pa1, bf16x8 pa2, bf16x8 pa3) {
  const s16x4 l0 = tr_read<v_rd_off(D0, 0, 0)>(vb), h0 = tr_read<v_rd_off(D0, 0, 1)>(vb), l1 = tr_read<v_rd_off(D0, 1, 0)>(vb), h1 = tr_read<v_rd_off(D0, 1, 1)>(vb);
  const s16x4 l2 = tr_read<v_rd_off(D0, 2, 0)>(vb), h2 = tr_read<v_rd_off(D0, 2, 1)>(vb), l3 = tr_read<v_rd_off(D0, 3, 0)>(vb), h3 = tr_read<v_rd_off(D0, 3, 1)>(vb);
  asm volatile("s_waitcnt lgkmcnt(0)" ::: "memory"); SBAR();
#define PK(L, H) (bf16x8){L[0], L[1], L[2], L[3], H[0], H[1], H[2], H[3]}
  od = __builtin_amdgcn_mfma_f32_32x32x16_bf16(pa0, PK(l0, h0), od, 0, 0, 0);
  od = __builtin_amdgcn_mfma_f32_32x32x16_bf16(pa1, PK(l1, h1), od, 0, 0, 0);
  od = __builtin_amdgcn_mfma_f32_32x32x16_bf16(pa2, PK(l2, h2), od, 0, 0, 0);
  od = __builtin_amdgcn_mfma_f32_32x32x16_bf16(pa3, PK(l3, h3), od, 0, 0, 0);
#undef PK
}
__device__ __forceinline__ void pv_d0(f32x16* o, int vb, bf16x8 pa0, bf16x8 pa1, bf16x8 pa2, bf16x8 pa3) {
  pv_one<0>(o[0], vb, pa0, pa1, pa2, pa3); pv_one<1>(o[1], vb, pa0, pa1, pa2, pa3); pv_one<2>(o[2], vb, pa0, pa1, pa2, pa3); pv_one<3>(o[3], vb, pa0, pa1, pa2, pa3);
}

__device__ __forceinline__ void attn_dense_body(const int PASS, const bf16* __restrict__ Qb, const bf16* __restrict__ Kh, const bf16* __restrict__ Vh,
                                                float* __restrict__ scr, bf16* __restrict__ Ob, float lam, int seq, char* lds) {
  int tid = threadIdx.x; asm volatile("" : "+v"(tid));
  const int wid = tid >> 6, lane = tid & 63, r32 = lane & 31, hi = lane >> 5;
  bf16* V_lds = (bf16*)lds; bf16* K_lds = (bf16*)(lds + 2 * SHM_V);
  float* ws = (float*)(lds + 2 * SHM_V + 2 * SHM_K) + wid * 64; float* li_l = ws; float* al_l = ws + 32;
  float m_reg = -1e30f, l_reg = 0; f32x16 o[4] = {}; bf16x8 qr[8];
  const bf16* Qw = Qb + (long)(wid * QBLK + r32) * LDQ + hi * 8;
#pragma unroll
  for (int d0 = 0; d0 < 8; ++d0) qr[d0] = ld8(Qw + d0 * 16);
  const int sr = tid >> 4, sc = (tid & 15) * 8, vst0 = v_st(sr, sc), vst1 = v_st(32 + sr, sc);
  const int vb0 = (int)(uintptr_t)V_lds + v_rd_base(lane);
  struct { bf16x8 vs0, vs1, ks0, ks1; } sr_[SDEPTH];
#define SLOAD(i, k0) do { sr_[i].vs0 = ld8(&Vh[(long)((k0) + sr) * LDK + sc]); sr_[i].vs1 = ld8(&Vh[(long)((k0) + 32 + sr) * LDK + sc]); \
    sr_[i].ks0 = ld8(&Kh[(long)((k0) + sr) * LDK + sc]); sr_[i].ks1 = ld8(&Kh[(long)((k0) + 32 + sr) * LDK + sc]); } while (0)
#define SWRITE(b, i) do { *(bf16x8*)((char*)V_lds + (b) * SHM_V + vst0) = sr_[i].vs0;          \
    *(bf16x8*)((char*)V_lds + (b) * SHM_V + vst1) = sr_[i].vs1; int kc = sc * 2;               \
    *(bf16x8*)((char*)K_lds + (b) * SHM_K + KSWZ(sr, kc)) = sr_[i].ks0;                       \
    *(bf16x8*)((char*)K_lds + (b) * SHM_K + KSWZ(32 + sr, kc)) = sr_[i].ks1; } while (0)
#define SWAIT() do { if constexpr (SDEPTH == 2) asm volatile("s_waitcnt vmcnt(4)" ::: "memory"); else asm volatile("s_waitcnt vmcnt(0)" ::: "memory"); } while (0)
#define RESC(a) do { if (__any((a) < 1.f)) { if (hi == 0) al_l[r32] = (a); asm volatile("s_waitcnt lgkmcnt(0)" ::: "memory"); \
    for (int d = 0; d < 4; ++d) for (int r = 0; r < 16; ++r) o[d][r] *= al_l[crow(r, hi)]; } } while (0)
  f32x16 pA0, pA1, pB0, pB1; float mnA, mnB, alA, alB; bf16x8 pa0, pa1, pa2, pa3; const int NT = seq / KVBLK;
  constexpr int SE = 0, SO = SDEPTH - 1;
  SLOAD(SE, 0); asm volatile("s_waitcnt vmcnt(0)" ::: "memory"); SWRITE(0, SE); __syncthreads();
  qkt(pA0, pA1, K_lds, qr, r32, hi); partialSM(pA0, pA1, m_reg, mnA, alA);
  SLOAD(SO, KVBLK); if constexpr (SDEPTH == 2) { if (2 < NT) SLOAD(SE, 2 * KVBLK); }
  SWAIT(); SWRITE(1, SO); __syncthreads();
  for (int j = 1; j + 1 < NT; j += 2) {
    SBAR(); qkt(pB0, pB1, (bf16*)((char*)K_lds + SHM_K), qr, r32, hi);
    finishSM(pA0, pA1, alA, l_reg, pa0, pa1, pa2, pa3); SBAR();
    SLOAD(SO, (j + SDEPTH) * KVBLK); SBAR();
    pv_d0(o, vb0, pa0, pa1, pa2, pa3); partialSM(pB0, pB1, m_reg, mnB, alB);
    __syncthreads(); SWAIT(); SWRITE(0, SE);
    RESC(alB); __syncthreads();
    SBAR(); qkt(pA0, pA1, K_lds, qr, r32, hi);
    finishSM(pB0, pB1, alB, l_reg, pa0, pa1, pa2, pa3); SBAR();
    if (SDEPTH == 1 || j + 3 < NT) SLOAD(SE, (j + 1 + SDEPTH) * KVBLK); SBAR();
    pv_d0(o, vb0 + (int)SHM_V, pa0, pa1, pa2, pa3); partialSM(pA0, pA1, m_reg, mnA, alA);
    __syncthreads(); SWAIT(); SWRITE(1, SO);
    RESC(alA); __syncthreads();
  }
  SBAR(); qkt(pB0, pB1, (bf16*)((char*)K_lds + SHM_K), qr, r32, hi);
  finishSM(pA0, pA1, alA, l_reg, pa0, pa1, pa2, pa3); SBAR();
  pv_d0(o, vb0, pa0, pa1, pa2, pa3); partialSM(pB0, pB1, m_reg, mnB, alB);
  __syncthreads(); RESC(alB);
  finishSM(pB0, pB1, alB, l_reg, pa0, pa1, pa2, pa3); SBAR();
  pv_d0(o, vb0 + (int)SHM_V, pa0, pa1, pa2, pa3);
  if (hi == 0) li_l[r32] = l_reg; asm volatile("s_waitcnt lgkmcnt(0)" ::: "memory");
  float rli[16];
#pragma unroll
  for (int r = 0; r < 16; ++r) rli[r] = __builtin_amdgcn_rcpf(li_l[crow(r, hi)]);
  float* sp = scr + tid;
  if (PASS == 0) {
#pragma unroll
    for (int r = 0; r < 16; ++r)
#pragma unroll
      for (int d0 = 0; d0 < 4; ++d0) sp[(d0 * 16 + r) * 512] = o[d0][r] * rli[r];
  } else {
    bf16* Ow = Ob + (long)(wid * QBLK) * LDQ;
#pragma unroll
    for (int r = 0; r < 16; ++r) { const int orow = crow(r, hi);
#pragma unroll
      for (int d0 = 0; d0 < 4; ++d0) { const float v = sp[(d0 * 16 + r) * 512] - lam * (o[d0][r] * rli[r]);
        Ow[(long)orow * LDQ + d0 * 32 + r32] = (bf16)(cvtpk(v, v) & 0xffffu); } }
  }
#undef SLOAD
#undef SWRITE
#undef SWAIT
#undef RESC
}
#undef KSWZ
#undef SBAR
}

namespace att2 {
using att::bf16; using att::bf16x8; using att::f32x16; using att::crow; using att::cvtpk;
constexpr int D = 128, NW = 8, QBLK = 32, KVBLK = 64, LDQ = 2048, LDK = 2048, NSLOT = 3;
constexpr int KSZ = KVBLK * D * 2, VSZ = KVBLK * 256 * 2;
constexpr int OFF_K = 0, OFF_V = NSLOT * KSZ, OFF_W = OFF_V + NSLOT * VSZ, LDS_ATT2 = OFF_W + NW * 256;
#define A2_LAS __attribute__((address_space(3)))

__device__ __forceinline__ void attn_pass(const int PASS, const bf16* __restrict__ Qb, const bf16* __restrict__ Kh, const bf16* __restrict__ Vh,
                                          float* __restrict__ scr, bf16* __restrict__ Ob, const float* __restrict__ gsub, float lam, int seq, char* lds, const float* __restrict__ rope_tab, int t0) {
  int tid = threadIdx.x; asm volatile("" : "+v"(tid));
  const int wid = __builtin_amdgcn_readfirstlane(tid >> 6), lane = tid & 63, r32 = lane & 31, hi = lane >> 5;
  float* wsc = (float*)(lds + OFF_W) + wid * 64; float* li_l = wsc; float* al_l = wsc + 32;
  float m_reg = -1e30f, l_reg = 0; f32x16 o[8] = {}; bf16x8 qr[8];
  const bf16* Qw = Qb + (long)(wid * QBLK + r32) * LDQ + hi * 8;
#pragma unroll
  for (int d0 = 0; d0 < 8; ++d0) qr[d0] = att::ld8(Qw + d0 * 16);
  if (rope_tab) {
    const int t = t0 + wid * QBLK + r32;
#pragma unroll
    for (int a = 0; a < 2; ++a) { const int pos = a ? (t & 63) : (t >> 6);
#pragma unroll
      for (int dd = 0; dd < 2; ++dd) { const att::f32x4v* tp = (const att::f32x4v*)(rope_tab + (pos * 32 + 16 * dd + 8 * hi) * 2);
        const att::u32x4 X1 = __builtin_bit_cast(att::u32x4, qr[4 * a + dd]), X2 = __builtin_bit_cast(att::u32x4, qr[4 * a + dd + 2]); att::u32x4 O1, O2;
#pragma unroll
        for (int e = 0; e < 4; ++e) { const att::f32x4v cs = tp[e];
          const float u1 = __uint_as_float(X1[e] << 16), v1 = __uint_as_float(X1[e] & 0xffff0000u), u2 = __uint_as_float(X2[e] << 16), v2 = __uint_as_float(X2[e] & 0xffff0000u);
          O1[e] = cvtpk(u1 * cs[0] - u2 * cs[1], v1 * cs[2] - v2 * cs[3]); O2[e] = cvtpk(u1 * cs[1] + u2 * cs[0], v1 * cs[3] + v2 * cs[2]); }
        qr[4 * a + dd] = __builtin_bit_cast(bf16x8, O1); qr[4 * a + dd + 2] = __builtin_bit_cast(bf16x8, O2); } }
  }
  int koff[2], voff[2];
#pragma unroll
  for (int i = 0; i < 2; ++i) {
    const int row = (i * 8 + wid) * 4 + (lane >> 4), chunk = (lane & 15) ^ (row & 7); koff[i] = row * LDK + chunk * 8;
    const int st = (i * 8 + wid) * 2 + (lane >> 5), kk = (st >> 2) * 8 + ((lane & 31) >> 2), c = (st & 3) * 32 + (lane & 3) * 8, k = (kk & ~0xC) | ((kk & 4) << 1) | ((kk & 8) >> 1);
    voff[i] = k * LDK + c; }
  const int vb0 = (int)(unsigned)(size_t)(A2_LAS char*)(lds + OFF_V) + att::v_rd_base(lane);
  const int NT = seq / KVBLK;
#define A2_ISSUE_K(t_, s_) do { const bf16* kt_ = Kh + (long)(t_) * KVBLK * LDK; A2_LAS char* kd_ = (A2_LAS char*)(lds + OFF_K) + (s_) * KSZ + wid * 1024; \
    __builtin_amdgcn_global_load_lds((const unsigned*)(kt_ + koff[0]), (A2_LAS unsigned*)(kd_), 16, 0, 0); __builtin_amdgcn_global_load_lds((const unsigned*)(kt_ + koff[1]), (A2_LAS unsigned*)(kd_ + 8192), 16, 0, 0); } while (0)
#define A2_ISSUE_V(t_, s_) do { const bf16* vt_ = Vh + (long)(t_) * KVBLK * LDK; A2_LAS char* vd_ = (A2_LAS char*)(lds + OFF_V) + (s_) * VSZ + wid * 1024; \
    __builtin_amdgcn_global_load_lds((const unsigned*)(vt_ + voff[0]), (A2_LAS unsigned*)(vd_), 16, 0, 0); __builtin_amdgcn_global_load_lds((const unsigned*)(vt_ + voff[1]), (A2_LAS unsigned*)(vd_ + 8192), 16, 0, 0); \
    __builtin_amdgcn_global_load_lds((const unsigned*)(vt_ + 128 + voff[0]), (A2_LAS unsigned*)(vd_ + 16384), 16, 0, 0); __builtin_amdgcn_global_load_lds((const unsigned*)(vt_ + 128 + voff[1]), (A2_LAS unsigned*)(vd_ + 16384 + 8192), 16, 0, 0); } while (0)
  asm volatile("s_waitcnt vmcnt(0) lgkmcnt(0)" ::: "memory"); __builtin_amdgcn_s_barrier(); asm volatile("" ::: "memory");
  A2_ISSUE_K(0, 0); A2_ISSUE_V(0, 0); if (NT > 1) A2_ISSUE_K(1, 1);
  const bool late = wid >= 4;
  int slot = 0; bf16x8 pa0, pa1, pa2, pa3;
#pragma unroll 1
  for (int j = 0; j < NT; ++j) {
    if (j + 1 < NT) asm volatile("s_waitcnt vmcnt(2)" ::: "memory"); else asm volatile("s_waitcnt vmcnt(0)" ::: "memory");
    asm volatile("s_waitcnt lgkmcnt(0)" ::: "memory"); __builtin_amdgcn_s_barrier(); asm volatile("" ::: "memory");
    const int sn = slot == 2 ? 0 : slot + 1, sp_ = slot == 0 ? 2 : slot - 1;
    if (j + 1 < NT) A2_ISSUE_V(j + 1, sn);
    if (j + 2 < NT) A2_ISSUE_K(j + 2, sp_);
    if (late && j > 0) { const int vb = vb0 + sp_ * VSZ; att::pv_d0(o, vb, pa0, pa1, pa2, pa3); att::pv_d0(o + 4, vb + 16384, pa0, pa1, pa2, pa3); }
    f32x16 p0, p1; float mn, al;
    att::qkt(p0, p1, (const bf16*)(lds + OFF_K + slot * KSZ), qr, r32, hi);
    att::partialSM(p0, p1, m_reg, mn, al);
    if (__any(al < 1.f)) { if (hi == 0) al_l[r32] = al; asm volatile("s_waitcnt lgkmcnt(0)" ::: "memory");
#pragma unroll
      for (int d = 0; d < 8; ++d)
#pragma unroll
        for (int r = 0; r < 16; ++r) o[d][r] *= al_l[crow(r, hi)]; }
    att::finishSM(p0, p1, al, l_reg, pa0, pa1, pa2, pa3);
    __builtin_amdgcn_sched_barrier(0);
    if (!late) { const int vb = vb0 + slot * VSZ; att::pv_d0(o, vb, pa0, pa1, pa2, pa3); att::pv_d0(o + 4, vb + 16384, pa0, pa1, pa2, pa3); }
    slot = sn;
  }
  if (late) { const int sl = slot == 0 ? 2 : slot - 1; const int vb = vb0 + sl * VSZ; att::pv_d0(o, vb, pa0, pa1, pa2, pa3); att::pv_d0(o + 4, vb + 16384, pa0, pa1, pa2, pa3); }
#undef A2_ISSUE_K
#undef A2_ISSUE_V
  if (hi == 0) li_l[r32] = l_reg; asm volatile("s_waitcnt lgkmcnt(0)" ::: "memory");
  float rli[16];
#pragma unroll
  for (int r = 0; r < 16; ++r) rli[r] = __builtin_amdgcn_rcpf(li_l[crow(r, hi)]);
  unsigned* sp = (unsigned*)scr + tid * 64;
  if (PASS == 0) {
#pragma unroll
    for (int d0 = 0; d0 < 8; ++d0)
#pragma unroll
      for (int r8 = 0; r8 < 2; ++r8) { const int r = 8 * r8;
        *(att::u32x4*)(sp + d0 * 8 + r8 * 4) = (att::u32x4){cvtpk(o[d0][r] * rli[r], o[d0][r + 1] * rli[r + 1]), cvtpk(o[d0][r + 2] * rli[r + 2], o[d0][r + 3] * rli[r + 3]),
                                                             cvtpk(o[d0][r + 4] * rli[r + 4], o[d0][r + 5] * rli[r + 5]), cvtpk(o[d0][r + 6] * rli[r + 6], o[d0][r + 7] * rli[r + 7])}; }
  } else {
    asm volatile("s_waitcnt lgkmcnt(0)" ::: "memory"); __builtin_amdgcn_s_barrier(); asm volatile("" ::: "memory");
    A2_LAS att::u32x4* lv = (A2_LAS att::u32x4*)((A2_LAS char*)lds + wid * 17408 + lane * 272);
    float ssq[16];
#pragma unroll
    for (int r = 0; r < 16; ++r) { ssq[r] = 0.f; rli[r] *= lam; }
#pragma unroll
    for (int d0 = 0; d0 < 8; ++d0)
#pragma unroll
      for (int r8 = 0; r8 < 2; ++r8) { const att::u32x4 s4 = *(const att::u32x4*)(sp + d0 * 8 + r8 * 4); att::u32x4 w4;
#pragma unroll
        for (int e = 0; e < 4; ++e) { const int r = 8 * r8 + 2 * e;
          const float v0 = __uint_as_float(s4[e] << 16) - o[d0][r] * rli[r], v1 = __uint_as_float(s4[e] & 0xffff0000u) - o[d0][r + 1] * rli[r + 1];
          ssq[r] = fmaf(v0, v0, ssq[r]); ssq[r + 1] = fmaf(v1, v1, ssq[r + 1]); w4[e] = cvtpk(v0, v1); }
        lv[d0 * 2 + r8] = w4; }
#pragma unroll
    for (int r = 0; r < 16; ++r) {
      float s = ssq[r]; s += __shfl_xor(s, 1); s += __shfl_xor(s, 2); s += __shfl_xor(s, 4); s += __shfl_xor(s, 8); s += __shfl_xor(s, 16);
      ssq[r] = 0.8f / sqrtf(s * (1.f / 256.f) + 1e-6f); }
    float gs8[8];
#pragma unroll
    for (int d0 = 0; d0 < 8; ++d0) gs8[d0] = gsub[d0 * 32 + r32];
    const int lofs = hi * 4 * 4096 + r32;
    __attribute__((address_space(1))) bf16* rowb = (__attribute__((address_space(1))) bf16*)(Ob + (long)(wid * QBLK) * 4096); asm volatile("" : "+s"(rowb));
#pragma unroll
    for (int d0 = 0; d0 < 8; ++d0) { const float g = gs8[d0];
#pragma unroll
      for (int r8 = 0; r8 < 2; ++r8) { const att::u32x4 w4 = lv[d0 * 2 + r8];
#pragma unroll
        for (int e = 0; e < 4; ++e) { const int r = 8 * r8 + 2 * e;
          const float v0 = __uint_as_float(w4[e] << 16) * ssq[r] * g, v1 = __uint_as_float(w4[e] & 0xffff0000u) * ssq[r + 1] * g;
          rowb[(long)((r & 3) + 8 * (r >> 2)) * 4096 + lofs + d0 * 32] = (bf16)(cvtpk(v0, v0) & 0xffffu);
          rowb[(long)(((r + 1) & 3) + 8 * ((r + 1) >> 2)) * 4096 + lofs + d0 * 32] = (bf16)(cvtpk(v1, v1) & 0xffffu); } } }
  }
}
#undef A2_LAS
}

constexpr int NWAVES = 8;
#ifndef PROBE_DUP
#define PROBE_DUP -1
#endif
constexpr int DM = 4096, MP = 8192, MS = 16384, MT = 24576;
constexpr int NINB = 7424;
constexpr int DFF = 16384, MLP_CH = 8192, N_MLP_CH = MT / MLP_CH;
constexpr int KVS = 4608;
constexpr float RMS_EPS = 1e-6f;
constexpr size_t MiB = 1u << 20;
constexpr size_t WS_CTL = 0, CTL_ZERO_BYTES = 1 * MiB;
constexpr size_t WS_MOD = 1 * MiB;
constexpr size_t WS_ROPE = 1 * MiB + 768 * 1024;
constexpr size_t WS_DEC = 1 * MiB + 512 * 1024;
constexpr size_t WS_PART = 2 * MiB;
constexpr size_t WS_WIN = 32 * MiB, WS_WOUT = 122 * MiB, WS_WUP = 154 * MiB, WS_WDN = 282 * MiB;
constexpr size_t WS_H = 410 * MiB;
constexpr size_t WS_ASCR = 410 * MiB;
constexpr size_t WS_Q = 602 * MiB, WS_KP = 698 * MiB, WS_KS = 730 * MiB, WS_VP = 802 * MiB, WS_VS = 834 * MiB, WS_Z = 906 * MiB;
constexpr size_t WS_XR = 1002 * MiB, WS_XC = 1146 * MiB, WS_DT = 1290 * MiB, WS_CAT = 1296 * MiB, WS_END = 1488 * MiB;
constexpr size_t WS_WINQ = 218 * MiB;
constexpr size_t WS_HQ = WS_CAT;
constexpr size_t WS_RST = 2 * MiB + 512 * 1024;
constexpr size_t WS_CATQ = WS_XR;
constexpr size_t WS_LMW = 122 * MiB;
constexpr size_t WS_WOUTQ = 90 * MiB;
constexpr size_t WS_X1 = WS_CAT;
constexpr size_t WS_MIX = 602 * MiB, WS_UP = 602 * MiB, WS_MOUT = 922 * MiB, WS_UPQ = 1114 * MiB;
constexpr int CW_BAR = 4096;
constexpr size_t WS_FOLD = 512 * 1024;
constexpr int CW_RMAX = 32768, CW_CMAX = 65536, CW_CS = 69632, CW_CMAXU = 73728, CW_CMAXI = 94208, CW_CMAXO = 106496;
constexpr size_t WS_SA = 2 * MiB, WS_SAH = 2 * MiB + 128 * 1024, WS_SB = 1 * MiB + 896 * 1024, WS_SBU = 1 * MiB + 912 * 1024, WS_SBI = 1 * MiB + 976 * 1024, WS_SAHI = 2 * MiB + 384 * 1024, WS_SBO = 1 * MiB + 576 * 1024, WS_SAC = 2 * MiB + 256 * 1024;
constexpr size_t O_YP = 0, O_YS = (size_t)MP * DM, O_NK = O_YS + (size_t)MS * DM, O_NV = O_NK + (size_t)MP * 2048, O_SF = O_NV + (size_t)MP * 2048, O_SB = O_SF + (size_t)32 * 32 * 64 * 128;
constexpr size_t OUT_TOTAL = O_SB + (size_t)32 * 32 * 64 * 128;
constexpr int LDS_BYTES = 163840, LDSCTL_OFF = LDS_BYTES - 512, MISC_OFF = LDSCTL_OFF + 320;

#define GAS __attribute__((address_space(1)))
#define LAS __attribute__((address_space(3)))
typedef unsigned short bf16;
typedef unsigned v4u __attribute__((ext_vector_type(4)));
typedef unsigned v2u __attribute__((ext_vector_type(2)));
typedef float f32x4 __attribute__((ext_vector_type(4)));
typedef short bf16x8 __attribute__((ext_vector_type(8)));
#define LDS_WAIT() asm volatile("s_waitcnt lgkmcnt(0)" ::: "memory")
#define VM_WAIT() asm volatile("s_waitcnt vmcnt(0)" ::: "memory")
__device__ __forceinline__ unsigned pkbf(float lo, float hi) { unsigned r; asm("v_cvt_pk_bf16_f32 %0, %1, %2" : "=v"(r) : "v"(lo), "v"(hi)); return r; }
__device__ __forceinline__ float bflo(unsigned u) { return __uint_as_float(u << 16); }
__device__ __forceinline__ float bfhi(unsigned u) { return __uint_as_float(u & 0xffff0000u); }
__device__ __forceinline__ float wave_sum(float v) {
#pragma unroll
    for (int o = 1; o < 64; o <<= 1) v += __shfl_xor(v, o);
    return v;
}
__device__ __forceinline__ float wave_incl_scan(float v, int lane) {
#pragma unroll
    for (int o = 1; o < 64; o <<= 1) { const float t = __shfl_up(v, o); if (lane >= o) v += t; }
    return v;
}
__device__ __forceinline__ float silu_f(float x) { return x / (1.f + __expf(-x)); }

static_assert(WS_UP + (size_t)MLP_CH * DFF * 2 <= WS_MOUT && WS_UPQ + (size_t)MLP_CH * DFF <= WS_CAT, "MLP buffers");
#define XB_TMO      128
#define XB_XCNT(j)  (256  + 64 * (j))
#define XB_XSUB(j)  (1280 + 64 * (j))
#define XB_XGEN(j)  (2304 + 64 * (j))
#define XB_TOP      3328
#define XB_TOPGEN   3392
#define XCD_BAR_WORDS 3456
#define XB_SPIN_CAP (1u << 18)

__device__ __forceinline__ unsigned xb_ld(unsigned* p)              { return __hip_atomic_load(p, __ATOMIC_RELAXED, __HIP_MEMORY_SCOPE_AGENT); }
__device__ __forceinline__ unsigned xb_add(unsigned* p, unsigned v) { return __hip_atomic_fetch_add(p, v, __ATOMIC_RELAXED, __HIP_MEMORY_SCOPE_AGENT); }
__device__ __forceinline__ unsigned xb_xcc_id() { return (unsigned)__builtin_amdgcn_s_getreg((3 << 11) | 20) & 0xFu; }
#define XB_SPIN(cond, bar) do { unsigned _sp = 0; while (cond) { __builtin_amdgcn_s_sleep(1); \
    if ((++_sp & 255u) == 0u) { if (xb_ld(&(bar)[XB_TMO])) break; if (_sp > XB_SPIN_CAP) { atomicAdd(&(bar)[XB_TMO], 1u); break; } } } } while (0)

struct XcdBarrier {
    unsigned* bar; unsigned x;
    volatile LAS unsigned* st;
};

__device__ __forceinline__ XcdBarrier xcd_barrier_post(unsigned* bar, volatile LAS unsigned* st) {
    XcdBarrier b; b.bar = bar; b.x = xb_xcc_id(); b.st = st;
    if (threadIdx.x == 0) (void)xb_add(&bar[XB_XCNT(b.x)], 1u);
    return b;
}
__device__ __forceinline__ void xcd_barrier_complete(unsigned* bar, unsigned x, unsigned& nloc, unsigned& nx) {
    const unsigned G = gridDim.x * gridDim.y * gridDim.z;
    unsigned sum, cnt, mine, sp = 0u;
    for (;;) {
        sum = 0u; cnt = 0u; mine = 0u;
#pragma unroll
        for (unsigned j = 0; j < 16; ++j) { const unsigned c = xb_ld(&bar[XB_XCNT(j)]); sum += c; cnt += (c > 0u) ? 1u : 0u; mine = (j == x) ? c : mine; }
        if (sum == G) break;
        __builtin_amdgcn_s_sleep(1);
        if ((++sp & 255u) == 0u) { if (xb_ld(&bar[XB_TMO])) break; if (sp > XB_SPIN_CAP) { atomicAdd(&bar[XB_TMO], 1u); break; } }
    }
    nloc = mine > 0u ? mine : 1u; nx = cnt > 0u ? cnt : 1u;
}

__device__ __forceinline__ void xcd_barrier(const XcdBarrier& b) {
    asm volatile("s_waitcnt vmcnt(0)" ::: "memory");
    __syncthreads();
    if (threadIdx.x == 0) {
        unsigned* bar = b.bar;
        __builtin_amdgcn_s_waitcnt(0);
        unsigned nloc = b.st[0], nx = b.st[1];
        if (nloc == 0u) { xcd_barrier_complete(bar, b.x, nloc, nx); b.st[0] = nloc; b.st[1] = nx; }
        const unsigned old = xb_add(&bar[XB_XSUB(b.x)], 1u);
        const unsigned gen = old / nloc;
        if (old + 1u == (gen + 1u) * nloc) {
            __builtin_amdgcn_fence(__ATOMIC_RELEASE, "agent");
            asm volatile("s_waitcnt vmcnt(0)" ::: "memory");
            const unsigned og = xb_add(&bar[XB_TOP], 1u);
            const unsigned tg = og / nx;
            if (og + 1u == (tg + 1u) * nx) xb_add(&bar[XB_TOPGEN], 1u);
            else XB_SPIN(xb_ld(&bar[XB_TOPGEN]) == tg, bar);
            __builtin_amdgcn_fence(__ATOMIC_ACQUIRE, "agent");
            xb_add(&bar[XB_XGEN(b.x)], 1u);
            asm volatile("s_waitcnt vmcnt(0)" ::: "memory");
        } else {
            XB_SPIN(xb_ld(&bar[XB_XGEN(b.x)]) == gen, bar);
            __builtin_amdgcn_fence(__ATOMIC_ACQUIRE, "agent");
            asm volatile("s_waitcnt vmcnt(0)" ::: "memory");
        }
    }
    __syncthreads();
}
struct Args { const float* in[29]; float* out; unsigned char* ws; int ph_lo, ph_hi; };
static_assert(sizeof(Args) == 29 * 8 + 8 + 8 + 8, "Args has no padding");
typedef const __attribute__((address_space(4))) Args CArgs;
#define ARGS_PTR() ({ CArgs* _a = (CArgs*)__builtin_amdgcn_kernarg_segment_ptr(); asm volatile("" : "+s"(_a)); _a; })
struct Frame {
    LAS unsigned char* lds;
    int tid, lane, wave, vcu, G;
};

#define Q4_MAGIC(v0, v1, v2, v3, s) __builtin_amdgcn_perm(__builtin_amdgcn_perm(__float_as_uint(fmaf((v3), (s), 12582912.f)), __float_as_uint(fmaf((v2), (s), 12582912.f)), 0x0c0c0400u), \
                                                          __builtin_amdgcn_perm(__float_as_uint(fmaf((v1), (s), 12582912.f)), __float_as_uint(fmaf((v0), (s), 12582912.f)), 0x0c0c0400u), 0x05040100u)
__device__ __forceinline__ void p0_transpose_item(const float* W, int K, int N, bf16* WT, LAS float* scr, int kb, int n0, int d0, int lane) {
    const int k0 = 64 * kb;
#pragma unroll 8
    for (int i = 0; i < 32; ++i) { const int kk = 2 * i + (lane >> 5); scr[kk * 33 + (lane & 31)] = W[(size_t)(k0 + kk) * N + n0 + (lane & 31)]; }
    LDS_WAIT(); asm volatile("" ::: "memory");
    const int c = lane & 7;
#pragma unroll
    for (int j = 0; j < 4; ++j) { const int n = (lane >> 3) + 8 * j; const LAS float* s = scr + (8 * c) * 33 + n;
        v4u o; o.x = pkbf(s[0 * 33], s[1 * 33]); o.y = pkbf(s[2 * 33], s[3 * 33]); o.z = pkbf(s[4 * 33], s[5 * 33]); o.w = pkbf(s[6 * 33], s[7 * 33]);
        *(GAS v4u*)(WT + (size_t)(d0 + n) * K + k0 + 8 * c) = o; }
    LDS_WAIT(); asm volatile("" ::: "memory");
}
template <bool ROT> __device__ __forceinline__ float tile_rot64(LAS float* scr, int lane) {
    const int n = lane & 31, kh = lane >> 5; float v[32];
#pragma unroll
    for (int i = 0; i < 32; ++i) v[i] = scr[(32 * kh + i) * 33 + n];
    if (ROT) {
#pragma unroll
        for (int s = 1; s < 32; s <<= 1)
#pragma unroll
            for (int i = 0; i < 32; ++i) if (!(i & s)) { const float a = v[i], b = v[i | s]; v[i] = a + b; v[i | s] = a - b; }
#pragma unroll
        for (int i = 0; i < 32; ++i) { const float o = __shfl_xor(v[i], 32); v[i] = (kh ? o - v[i] : v[i] + o) * 0.125f; }
#pragma unroll
        for (int i = 0; i < 32; ++i) scr[(32 * kh + i) * 33 + n] = v[i];
        LDS_WAIT(); asm volatile("" ::: "memory");
    }
    float mx = 0.f;
#pragma unroll
    for (int i = 0; i < 32; ++i) mx = fmaxf(mx, fabsf(v[i]));
    return fmaxf(mx, __shfl_xor(mx, 32));
}
__device__ __forceinline__ void ada_item(Frame& F, CArgs* A, int it, int lane_) {
    const int lane = lane_, kc = it / 96, cb = it % 96, k0 = kc * 64, n0 = cb * 256 + lane * 4;
    float cv[5];
    cv[0] = silu_f((A->in[7])[k0 + lane]);
#pragma unroll
    for (int v = 1; v < 5; ++v) cv[v] = silu_f((A->in[2])[(v - 1) * DM + k0 + lane]);
    f32x4 acc[5];
#pragma unroll
    for (int v = 0; v < 5; ++v) acc[v] = (f32x4){0.f, 0.f, 0.f, 0.f};
    const float* wp = (A->in[8]) + (size_t)k0 * 24576 + n0;
#pragma unroll
    for (int kh = 0; kh < 2; ++kh) { f32x4 w[32];
#pragma unroll
        for (int kk = 0; kk < 32; ++kk) w[kk] = *(const GAS f32x4*)(wp + (size_t)(32 * kh + kk) * 24576);
#pragma unroll
        for (int kk = 0; kk < 32; ++kk)
#pragma unroll
            for (int v = 0; v < 5; ++v) { const float s = __builtin_bit_cast(float, __builtin_amdgcn_readlane(__builtin_bit_cast(int, cv[v]), 32 * kh + kk)); acc[v] += w[kk] * s; } }
#pragma unroll
    for (int v = 0; v < 5; ++v) *(GAS f32x4*)(((float*)(A->ws + WS_PART)) + (size_t)(kc * 5 + v) * 24576 + n0) = acc[v];
}
__device__ __forceinline__ void p0_prologue(Frame& F) {
    CArgs* A = ARGS_PTR(); int tid_ = (int)threadIdx.x; asm volatile("" : "+v"(tid_)); const int lane_ = tid_ & 63;
    LAS float* scr = (LAS float*)(F.lds + F.wave * 16384);
    const int gw = F.vcu * NWAVES + F.wave, NGW = F.G * NWAVES;
    const int gt = F.vcu * 512 + tid_, NT = F.G * 512;
    for (int it = gw; it < 64 * 96; it += NGW) ada_item(F, A, it, lane_);
    constexpr int NB_IN = 128 + 98, I_IN = 64 * NB_IN, I_OUT = 64 * 128;
    for (int it = gw; it < I_IN + I_OUT; it += NGW) {
        if (it < I_IN) { const int kb = it / NB_IN, nbv = it - kb * NB_IN, n0 = nbv < 128 ? 2048 + 32 * nbv : 8192 + 32 * (nbv - 128);
            p0_transpose_item((A->in[14]), DM, 11328, ((bf16*)(A->ws + WS_WIN)), scr, kb, n0, n0 - (nbv < 128 ? 2048 : 4096), lane_); }
        else { const int r = it - I_IN, kb = r >> 7, nb = r & 127, k0 = 64 * kb, n0 = 32 * nb; const float* W = A->in[26];
#pragma unroll 8
            for (int i = 0; i < 32; ++i) { const int kk = 2 * i + (lane_ >> 5); scr[kk * 33 + (lane_ & 31)] = W[(size_t)(k0 + kk) * DM + n0 + (lane_ & 31)]; }
            LDS_WAIT(); asm volatile("" ::: "memory");
            const float mx = tile_rot64<true>(scr, lane_);
            if (lane_ < 32) __hip_atomic_fetch_max((unsigned*)(A->ws + WS_CTL) + CW_CMAXO + n0 + lane_, __float_as_uint(mx), __ATOMIC_RELAXED, __HIP_MEMORY_SCOPE_AGENT);
            LDS_WAIT(); asm volatile("" ::: "memory"); }
    }
    {   unsigned* cmax = (unsigned*)(A->ws + WS_CTL) + CW_CMAXI; const float* wi = A->in[14];
        for (int it = gw; it < 64 * 44; it += NGW) { const int kb = it / 44, cb = it - kb * 44, v0 = cb * 256; const float* wp = wi + (size_t)(kb * 64) * 11328 + (v0 < 2048 ? v0 : (v0 < 4096 ? v0 + 4096 : (v0 < 8192 ? v0 - 2048 : v0))) + lane_ * 4;
            f32x4 mx = (f32x4){0.f, 0.f, 0.f, 0.f};
#pragma unroll 16
            for (int kk = 0; kk < 64; ++kk) { const f32x4 w = *(const GAS f32x4*)(wp + (size_t)kk * 11328); mx = (f32x4){fmaxf(mx[0], fabsf(w[0])), fmaxf(mx[1], fabsf(w[1])), fmaxf(mx[2], fabsf(w[2])), fmaxf(mx[3], fabsf(w[3]))}; }
#pragma unroll
            for (int e = 0; e < 4; ++e) __hip_atomic_fetch_max(cmax + cb * 256 + lane_ * 4 + e, __float_as_uint(mx[e]), __ATOMIC_RELAXED, __HIP_MEMORY_SCOPE_AGENT); }
    }
    {
#define P0_SRC(item_, wp_, ldw_) do { const int w_ = (item_) >= 32768, it_ = (item_) - w_ * 32768; const int N_ = w_ ? DFF : DM, nblk_ = N_ / 32, kb_ = it_ / nblk_, n0_ = 32 * (it_ - kb_ * nblk_); \
            ldw_ = N_; wp_ = (w_ ? A->in[27] : A->in[28]) + (size_t)(64 * kb_ + (lane_ >> 5)) * ldw_ + n0_ + (lane_ & 31); } while (0)
        constexpr int P0_ITEMS = 2 * 32768;
        float tl[32];
        if (gw < P0_ITEMS) { const float* wp; int ldw; P0_SRC(gw, wp, ldw);
#pragma unroll
            for (int i = 0; i < 32; ++i) tl[i] = wp[(size_t)(2 * i) * ldw]; }
#pragma unroll 1
        for (int item = gw; item < P0_ITEMS; item += NGW) {
            const int which = item >= 32768, it = item - which * 32768;
            const int K = which ? DM : DFF, N = which ? DFF : DM, nblk = N / 32, kb = it / nblk, nb = it - kb * nblk, k0 = 64 * kb, n0 = 32 * nb;
            unsigned char* WQ = (unsigned char*)(A->ws + (which ? WS_WUP : WS_WDN)); float* LM = (float*)(A->ws + WS_LMW + (which ? 4 * MiB : 0));
#pragma unroll
            for (int i = 0; i < 32; ++i) scr[(2 * i + (lane_ >> 5)) * 33 + (lane_ & 31)] = tl[i];
            asm volatile("" ::: "memory");
            {   const int nx = item + NGW < P0_ITEMS ? item + NGW : P0_ITEMS - 1; const float* wp; int ldw; P0_SRC(nx, wp, ldw);
#pragma unroll
                for (int i = 0; i < 32; ++i) tl[i] = wp[(size_t)(2 * i) * ldw]; }
            LDS_WAIT(); asm volatile("" ::: "memory");
            const int c = lane_ & 7;
#pragma unroll
            for (int j = 0; j < 4; ++j) { const int n = (lane_ >> 3) + 8 * j; const LAS float* s = scr + (8 * c) * 33 + n;
                float w8[8], lm = 0.f;
#pragma unroll
                for (int e = 0; e < 8; ++e) { w8[e] = s[e * 33]; lm = fmaxf(lm, fabsf(w8[e])); }
                lm = fmaxf(lm, __shfl_xor(lm, 1)); lm = fmaxf(lm, __shfl_xor(lm, 2)); lm = fmaxf(lm, __shfl_xor(lm, 4));
                const float inv = lm > 0.f ? 127.f / lm : 0.f; unsigned lo = 0u, hi = 0u;
#pragma unroll
                for (int e = 0; e < 4; ++e) { lo |= (unsigned)(__float2int_rn(w8[e] * inv) & 0xff) << (8 * e); hi |= (unsigned)(__float2int_rn(w8[4 + e] * inv) & 0xff) << (8 * e); }
                *(GAS v2u*)(WQ + (size_t)(n0 + n) * K + k0 + 8 * c) = (v2u){lo, hi};
                LM[(size_t)(n0 + n) * (K >> 6) + kb] = lm; }
            LDS_WAIT(); asm volatile("" ::: "memory");
        }
#undef P0_SRC
    }
    for (int i = gt; i < 64 * 32; i += NT) { const float inv = exp2f(-(float)(2 * (i & 31)) * (13.287712379549449f / 64.f)); float s, c; sincosf((float)(i >> 5) * inv, &s, &c); ((float*)(A->ws + WS_ROPE))[2 * i] = c; ((float*)(A->ws + WS_ROPE))[2 * i + 1] = s; }
    for (int i = gt; i < 192 * DM / 8; i += NT) *(GAS v4u*)(((bf16*)(A->ws + WS_WIN)) + (size_t)7232 * DM + (size_t)i * 8) = (v4u){0u, 0u, 0u, 0u};
    for (int i = gt; i < 2 * 524288; i += NT) { const int which = i >= 524288, j = i - which * 524288, row = j >> 8, c8 = (j & 255) * 8, b = row >> 9, t = row & 511;
        const float* src = (which ? (A->in[4]) : (A->in[3])) + (size_t)row * 2048 + c8; const f32x4 a = *(const GAS f32x4*)src, bb = *(const GAS f32x4*)(src + 4);
        v4u o; o.x = pkbf(a[0], a[1]); o.y = pkbf(a[2], a[3]); o.z = pkbf(bb[0], bb[1]); o.w = pkbf(bb[2], bb[3]);
        *(GAS v4u*)((which ? ((bf16*)(A->ws + WS_VS)) : ((bf16*)(A->ws + WS_KS))) + ((size_t)b * KVS + t) * 2048 + c8) = o; }
}
__device__ __forceinline__ void p1_mod(Frame& F) {
    CArgs* A = ARGS_PTR(); int tid_ = (int)threadIdx.x; asm volatile("" : "+v"(tid_)); const int lane_ = tid_ & 63;
    const int gt = F.vcu * 512 + tid_, NT = F.G * 512;
    for (int i = gt; i < 5 * 24576; i += NT) { const int v = i / 24576, n = i - v * 24576; float s = (A->in[9])[n];
#pragma unroll 8
        for (int kc = 0; kc < 64; ++kc) s += ((float*)(A->ws + WS_PART))[(size_t)(kc * 5 + v) * 24576 + n];
        ((float*)(A->ws + WS_MOD))[i] = s;
        {   const int ch = n >> 12, c = n & 4095; float* fo = (float*)(A->ws + WS_FOLD) + (size_t)v * 16384 + c;
            if (ch == 1) fo[0] = (A->in[10])[c] * (1.f + s); else if (ch == 2) fo[4096] = s * (A->in[11])[c]; else if (ch == 4) fo[8192] = (A->in[12])[c] * (1.f + s); else if (ch == 5) fo[12288] = s * (A->in[13])[c]; } }
    {   LAS float* scr = (LAS float*)(F.lds + F.wave * 16384);
        const int gw = F.vcu * NWAVES + F.wave, NGW = F.G * NWAVES, lane = lane_;
#define P1_SRC(item_, wp_, ldw_) do { const int w_ = (item_) >= 88064 ? 3 : ((item_) >= 65536 ? 2 : ((item_) >= 32768 ? 1 : 0)), it_ = (item_) - (w_ == 3 ? 88064 : w_ * 32768); \
            const int N_ = w_ == 1 ? DFF : (w_ == 2 ? 11264 : DM), nblk_ = N_ / 32, kb_ = it_ / nblk_, n0_ = 32 * (it_ - kb_ * nblk_); \
            ldw_ = w_ == 2 ? 11328 : N_; const int coff_ = w_ != 2 ? 0 : (n0_ < 2048 ? 0 : (n0_ < 4096 ? 4096 : (n0_ < 8192 ? -2048 : 0))); \
            wp_ = (w_ == 0 ? A->in[28] : (w_ == 1 ? A->in[27] : (w_ == 2 ? A->in[14] : A->in[26]))) + (size_t)(64 * kb_ + (lane >> 5)) * ldw_ + coff_ + n0_ + (lane & 31); } while (0)
        constexpr int P1_ITEMS = 2 * 32768 + 22528 + 8192;
        float tl[32];
        constexpr int P1_FIRST = 2 * 32768;
        if (P1_FIRST + gw < P1_ITEMS) { const float* wp; int ldw; P1_SRC(P1_FIRST + gw, wp, ldw);
#pragma unroll
            for (int i = 0; i < 32; ++i) tl[i] = wp[(size_t)(2 * i) * ldw]; }
#pragma unroll 1
        for (int item = P1_FIRST + gw; item < P1_ITEMS; item += NGW) {
            const int which = item >= 88064 ? 3 : (item >= 65536 ? 2 : (item >= 32768 ? 1 : 0)); const bool up = which != 0; const int it = item - (which == 3 ? 88064 : which * 32768);
            const int K = which == 0 ? DFF : DM, N = which == 1 ? DFF : (which == 2 ? 11264 : DM), nblk = N / 32, kb = it / nblk, nb = it - kb * nblk, k0 = 64 * kb, n0 = 32 * nb;
            unsigned char* WQ = (unsigned char*)(A->ws + (which == 0 ? WS_WDN : (which == 1 ? WS_WUP : (which == 2 ? WS_WINQ : WS_WOUTQ))));
            const unsigned* cmax = (const unsigned*)(A->ws + WS_CTL) + (which == 0 ? CW_CMAX : (which == 1 ? CW_CMAXU : (which == 2 ? CW_CMAXI : CW_CMAXO))); float* SB = (float*)(A->ws + (which == 0 ? WS_SB : (which == 1 ? WS_SBU : (which == 2 ? WS_SBI : WS_SBO)))); int* CS = (int*)(A->ws + WS_CTL) + CW_CS;
#pragma unroll
            for (int i = 0; i < 32; ++i) scr[(2 * i + (lane >> 5)) * 33 + (lane & 31)] = tl[i];
            float cmj[4];
#pragma unroll
            for (int j = 0; j < 4; ++j) cmj[j] = __uint_as_float(cmax[n0 + (lane >> 3) + 8 * j]);
            asm volatile("" ::: "memory");
            {   const int nx = item + NGW < P1_ITEMS ? item + NGW : P1_ITEMS - 1;
                const float* wp; int ldw; P1_SRC(nx, wp, ldw);
#pragma unroll
                for (int i = 0; i < 32; ++i) tl[i] = wp[(size_t)(2 * i) * ldw]; }
            LDS_WAIT(); asm volatile("" ::: "memory");
            if (which == 3) (void)tile_rot64<true>(scr, lane);
            const int c = lane & 7;
#pragma unroll
            for (int j = 0; j < 4; ++j) { const int n = (lane >> 3) + 8 * j; const LAS float* s = scr + (8 * c) * 33 + n;
                const float cm = cmj[j], inv = cm > 0.f ? 127.f / cm : 0.f;
                int q[8], sum = 0;
#pragma unroll
                for (int e = 0; e < 8; ++e) { int t = __float2int_rn(s[e * 33] * inv); t = t > 127 ? 127 : (t < -127 ? -127 : t); q[e] = t; sum += t; }
                const unsigned lo = (unsigned)(q[0] & 0xff) | ((unsigned)(q[1] & 0xff) << 8) | ((unsigned)(q[2] & 0xff) << 16) | ((unsigned)(q[3] & 0xff) << 24);
                const unsigned hi = (unsigned)(q[4] & 0xff) | ((unsigned)(q[5] & 0xff) << 8) | ((unsigned)(q[6] & 0xff) << 16) | ((unsigned)(q[7] & 0xff) << 24);
                *(GAS v2u*)(WQ + (size_t)(n0 + n) * K + k0 + 8 * c) = (v2u){lo, hi};
                sum += __shfl_xor(sum, 1); sum += __shfl_xor(sum, 2); sum += __shfl_xor(sum, 4);
                if (c == 0) { if (!up) __hip_atomic_fetch_add(CS + n0 + n, sum, __ATOMIC_RELAXED, __HIP_MEMORY_SCOPE_AGENT); if (kb == 0) SB[n0 + n] = cm * (1.f / 127.f); } }
            LDS_WAIT(); asm volatile("" ::: "memory");
        }
#undef P1_SRC
#define WQ_ROW4(rowp_, lmp_, ci_, sum_) do { v4u v_[4]; float lm_[4]; \
            _Pragma("unroll") for (int j = 0; j < 4; ++j) { v_[j] = *(const GAS v4u*)((rowp_) + j * 1024 + 16 * lane); lm_[j] = (lmp_)[16 * j + (lane >> 2)]; } \
            _Pragma("unroll") for (int j = 0; j < 4; ++j) { const float ratio = lm_[j] * (ci_); v4u o_; \
                _Pragma("unroll") for (int e = 0; e < 4; ++e) { const unsigned x = v_[j][e]; \
                    const int q0 = __float2int_rn((float)((int)(x << 24) >> 24) * ratio), q1 = __float2int_rn((float)((int)(x << 16) >> 24) * ratio), q2 = __float2int_rn((float)((int)(x << 8) >> 24) * ratio), q3 = __float2int_rn((float)((int)x >> 24) * ratio); \
                    o_[e] = (unsigned)(q0 & 0xff) | ((unsigned)(q1 & 0xff) << 8) | ((unsigned)(q2 & 0xff) << 16) | ((unsigned)q3 << 24); \
                    sum_ = __builtin_amdgcn_sad_u8(o_[e] ^ 0x80808080u, 0u, sum_); }                        \
                *(GAS v4u*)((rowp_) + j * 1024 + 16 * lane) = o_; } } while (0)
#pragma unroll 1
        for (int r = gw; r < 4096; r += NGW) {
            unsigned char* rowp = (unsigned char*)(A->ws + WS_WDN) + (size_t)r * DFF; const float* lmp = (const float*)(A->ws + WS_LMW) + (size_t)r * 256;
            float cm = fmaxf(fmaxf(lmp[lane], lmp[64 + lane]), fmaxf(lmp[128 + lane], lmp[192 + lane]));
#pragma unroll
            for (int o = 1; o < 64; o <<= 1) cm = fmaxf(cm, __shfl_xor(cm, o));
            const float ci = cm > 0.f ? 1.f / cm : 0.f; unsigned sum = 0u;
#pragma unroll 1
            for (int qd = 0; qd < 4; ++qd) { WQ_ROW4(rowp + qd * 4096, lmp + qd * 64, ci, sum); }
#pragma unroll
            for (int o = 1; o < 64; o <<= 1) sum += __shfl_xor(sum, o);
            if (lane == 0) { ((int*)(A->ws + WS_CTL))[CW_CS + r] = (int)sum - 128 * DFF; ((float*)(A->ws + WS_SB))[r] = cm * (1.f / 127.f); } }
#pragma unroll 1
        for (int r = gw; r < 16384; r += NGW) {
            unsigned char* rowp = (unsigned char*)(A->ws + WS_WUP) + (size_t)r * DM; const float* lmp = (const float*)(A->ws + WS_LMW + 4 * MiB) + (size_t)r * 64;
            float cm = lmp[lane];
#pragma unroll
            for (int o = 1; o < 64; o <<= 1) cm = fmaxf(cm, __shfl_xor(cm, o));
            const float ci = cm > 0.f ? 1.f / cm : 0.f; unsigned sum = 0u;
            WQ_ROW4(rowp, lmp, ci, sum); (void)sum;
            if (lane == 0) ((float*)(A->ws + WS_SBU))[r] = cm * (1.f / 127.f); }
#undef WQ_ROW4
    }
}
__device__ __forceinline__ void p11_requant(Frame& F, const int ch, unsigned char* UPQb, const float* LMb) {
    CArgs* A = ARGS_PTR(); int tid_ = (int)threadIdx.x; asm volatile("" : "+v"(tid_)); const int lane = tid_ & 63;
    const int gw = F.vcu * NWAVES + F.wave, NGW = F.G * NWAVES;
    float* SA = (float*)(A->ws + WS_SA) + ch * MLP_CH;
    const int lidx = 4 * (lane >> 4) + ((lane >> 1) & 3);
#pragma unroll 1
    for (int r = gw; r < MLP_CH; r += NGW) {
        unsigned char* rowp = UPQb + (size_t)r * DFF + 16 * lane; const float* lmp = LMb + (size_t)r * 256 + lidx;
        v4u v[16]; float lm[16];
#pragma unroll
        for (int j = 0; j < 16; ++j) { v[j] = *(const GAS v4u*)(rowp + j * 1024); lm[j] = lmp[16 * j]; }
        float gm = 0.f;
#pragma unroll
        for (int j = 0; j < 16; ++j) gm = fmaxf(gm, lm[j]);
#pragma unroll
        for (int o = 1; o < 64; o <<= 1) gm = fmaxf(gm, __shfl_xor(gm, o));
        const float ginv = gm > 0.f ? 1.f / gm : 0.f; if (lane == 0) SA[r] = gm * (1.f / 255.f);
#pragma unroll
        for (int j = 0; j < 16; ++j) { const float ratio = lm[j] * ginv; v4u o;
#pragma unroll
            for (int e = 0; e < 4; ++e) { const unsigned x = v[j][e] ^ 0x80808080u;
                o[e] = Q4_MAGIC((float)(x & 0xffu), (float)((x >> 8) & 0xffu), (float)((x >> 16) & 0xffu), (float)(x >> 24), ratio) ^ 0x80808080u; }
            *(GAS v4u*)(rowp + j * 1024) = o; }
    }
}
#define ROW_PREFETCH(xl_, xrow_) do { const char* g_ = (const char*)(xrow_) + lane * 16; \
        _Pragma("unroll") for (int j = 0; j < 16; ++j) __builtin_amdgcn_global_load_lds((const unsigned*)(g_ + j * 1024), (LAS unsigned*)((xl_) + j * 1024), 16, 0, 0); } while (0)
#define ROW_FROM_LDS(X, xl_) do { _Pragma("unroll") for (int j = 0; j < 16; ++j) X[j] = *(const LAS f32x4*)((xl_) + j * 1024 + lane * 16); LDS_WAIT(); } while (0)
__device__ __forceinline__ void p2_h(Frame& F) {
    CArgs* A = ARGS_PTR(); int tid_ = (int)threadIdx.x; asm volatile("" : "+v"(tid_)); const int lane_ = tid_ & 63;
    const int gw = F.vcu * NWAVES + F.wave, NGW = F.G * NWAVES, lane = lane_;
    const float* MODp = (const float*)(A->ws + WS_MOD); bf16* Hb = (bf16*)(A->ws + WS_H);
    LAS unsigned char* xl = F.lds + F.wave * 16384;
#define XROW(r_) ((r_) < MP ? (A->in[0]) + (size_t)(r_) * DM : (A->in[1]) + (size_t)((r_) - MP) * DM)
#define ROW_FROM_LDS8(X, xl_) do { _Pragma("unroll") for (int j = 0; j < 8; ++j) { X[2 * j] = *(const LAS f32x4*)((xl_) + j * 2048 + lane * 32); X[2 * j + 1] = *(const LAS f32x4*)((xl_) + j * 2048 + lane * 32 + 16); } LDS_WAIT(); } while (0)
    LAS unsigned char* vst = F.lds + 131072; int cur_vi = -1;
    int r = gw; if (r < MT) ROW_PREFETCH(xl, XROW(r));
#pragma unroll 1
    for (; r < MT; r += NGW) {
        f32x4 v[16];
        const int vi = r < MP ? 0 : 1 + ((r - MP) >> 12);
        if (vi != cur_vi) { __syncthreads();
#pragma unroll
            for (int i = 0; i < 4; ++i) { const int pc = tid_ + 512 * i, vv = pc >> 10, c = (pc & 1023) * 4; const float* s = vv == 0 ? (const float*)(A->ws + WS_FOLD) + vi * 16384 : MODp + vi * 24576;
                const f32x4 a = *(const GAS f32x4*)(s + c); *(LAS v2u*)(vst + vv * 8192 + c * 2) = (v2u){pkbf(a[0], a[1]), pkbf(a[2], a[3])}; }
            LDS_WAIT(); __syncthreads(); cur_vi = vi; }
        VM_WAIT(); ROW_FROM_LDS8(v, xl);
        const int rn = r + NGW; if (rn < MT) ROW_PREFETCH(xl, XROW(rn));
        float ss = 0.f;
#pragma unroll
        for (int j = 0; j < 16; ++j) ss += (v[j][0] * v[j][0] + v[j][1] * v[j][1]) + (v[j][2] * v[j][2] + v[j][3] * v[j][3]);
        const float rstd = 1.f / sqrtf(wave_sum(ss) * (1.f / DM) + RMS_EPS); bf16* hr = Hb + (size_t)r * DM + 8 * lane; float hm = 0.f;
#pragma unroll
        for (int j = 0; j < 8; ++j) { const v4u gq = *(const LAS v4u*)(vst + (512 * j + 8 * lane) * 2), sq = *(const LAS v4u*)(vst + 8192 + (512 * j + 8 * lane) * 2);
#pragma unroll
            for (int hh = 0; hh < 2; ++hh) { const int k = 2 * j + hh;
                const f32x4 gs = (f32x4){bflo(gq[2 * hh]), bfhi(gq[2 * hh]), bflo(gq[2 * hh + 1]), bfhi(gq[2 * hh + 1])}, sh = (f32x4){bflo(sq[2 * hh]), bfhi(sq[2 * hh]), bflo(sq[2 * hh + 1]), bfhi(sq[2 * hh + 1])};
                v[k] = (v[k] * rstd) * gs + sh;
                hm = fmaxf(hm, fmaxf(fmaxf(fabsf(v[k][0]), fabsf(v[k][1])), fmaxf(fabsf(v[k][2]), fabsf(v[k][3])))); }
            *(GAS v4u*)(hr + 512 * j) = (v4u){pkbf(v[2 * j][0], v[2 * j][1]), pkbf(v[2 * j][2], v[2 * j][3]), pkbf(v[2 * j + 1][0], v[2 * j + 1][1]), pkbf(v[2 * j + 1][2], v[2 * j + 1][3])}; }
#pragma unroll
        for (int o = 1; o < 64; o <<= 1) hm = fmaxf(hm, __shfl_xor(hm, o));
        const float hinv = hm > 0.f ? 127.f / hm : 0.f; if (lane == 0) ((float*)(A->ws + WS_SAHI))[r] = hm * (1.f / 127.f);
        unsigned char* hq = (unsigned char*)(A->ws + WS_HQ) + (size_t)r * DM + 8 * lane;
#pragma unroll
        for (int j = 0; j < 8; ++j) { unsigned w2[2];
#pragma unroll
            for (int hh = 0; hh < 2; ++hh) { const int k = 2 * j + hh; w2[hh] = Q4_MAGIC(v[k][0], v[k][1], v[k][2], v[k][3], hinv); }
            *(GAS v2u*)(hq + 512 * j) = (v2u){w2[0], w2[1]}; }
    }
}
__device__ __forceinline__ void p4_rope_conv(Frame& F) {
    CArgs* A = ARGS_PTR(); int tid_ = (int)threadIdx.x; asm volatile("" : "+v"(tid_)); const int lane_ = tid_ & 63;
    const int gw = F.vcu * NWAVES + F.wave, NGW = F.G * NWAVES, lane = lane_;
    const int gt = F.vcu * 512 + tid_, NT = F.G * 512;
    {   const int u = lane >> 1, hh = u >> 1, a = u & 1, m = lane & 1;
        const float* TAB = (const float*)(A->ws + WS_ROPE);
#define ROPE_ROW(it_) ({ const int sr_ = (it_), b_ = sr_ >> 12, t_ = sr_ & 4095; \
            ((bf16*)(A->ws + WS_KS)) + ((size_t)b_ * KVS + 512 + t_) * 2048 + hh * 128 + a * 64 + 16 * m; })
        v4u xn[4];
        if (gw < MS) { const GAS v4u* q1 = (const GAS v4u*)ROPE_ROW(gw); xn[0] = q1[0]; xn[1] = q1[1]; xn[2] = q1[4]; xn[3] = q1[5]; }
#pragma unroll 1
        for (int it = gw; it < MS; it += NGW) {
            const int t = it & 4095;
            const int pos = a ? (t & 63) : (t >> 6);
            GAS v4u* p1 = (GAS v4u*)ROPE_ROW(it); GAS v4u* p2 = p1 + 4;
            const GAS f32x4* tp = (const GAS f32x4*)(TAB + (pos * 32 + 16 * m) * 2);
            f32x4 csv[8];
#pragma unroll
            for (int e = 0; e < 8; ++e) csv[e] = tp[e];
            const v4u x1a = xn[0], x1b = xn[1], x2a = xn[2], x2b = xn[3];
            asm volatile("" ::: "memory");
            {   const int nx = it + NGW < MS ? it + NGW : MS - 1; const GAS v4u* q1 = (const GAS v4u*)ROPE_ROW(nx); xn[0] = q1[0]; xn[1] = q1[1]; xn[2] = q1[4]; xn[3] = q1[5]; }
            asm volatile("" ::: "memory");
            v4u o1a, o1b, o2a, o2b;
#define ROPE4(X1, X2, O1, O2, k0_) do { _Pragma("unroll") for (int e = 0; e < 4; ++e) { const f32x4 cs = csv[(k0_) + e]; \
                const float u1 = bflo(X1[e]), v1 = bfhi(X1[e]), u2 = bflo(X2[e]), v2 = bfhi(X2[e]); \
                O1[e] = pkbf(u1 * cs[0] - u2 * cs[1], v1 * cs[2] - v2 * cs[3]); O2[e] = pkbf(u1 * cs[1] + u2 * cs[0], v1 * cs[3] + v2 * cs[2]); } } while (0)
            ROPE4(x1a, x2a, o1a, o2a, 0); ROPE4(x1b, x2b, o1b, o2b, 4);
#undef ROPE4
            p1[0] = o1a; p1[1] = o1b; p2[0] = o2a; p2[1] = o2b;
        }
#undef ROPE_ROW
    }
    for (int it = gw; it < 1536 * 6; it += NGW) {
        const int tb = it / 6, cg = it - tb * 6, t0 = tb * 16, c0 = cg * 512 + lane * 8;
        int seq_lo, seq_hi; if (t0 < MP) { seq_lo = t0 & ~255; seq_hi = seq_lo + 256; } else { seq_lo = MP + ((t0 - MP) & ~4095); seq_hi = seq_lo + 4096; }
        v4u raw[20];
        const bf16* xin = ((const bf16*)(A->ws + WS_XR)) + c0;
#pragma unroll
        for (int i = 0; i < 20; ++i) { const int t = t0 - 2 + i; raw[i] = (v4u){0u, 0u, 0u, 0u}; if (t >= seq_lo && t < seq_hi) raw[i] = *(const GAS v4u*)(xin + (size_t)t * 3072); }
        float w[5][8], bias[8];
#pragma unroll
        for (int j = 0; j < 5; ++j) { const f32x4 a0 = *(const GAS f32x4*)((A->in[20]) + j * 3072 + c0), a1 = *(const GAS f32x4*)((A->in[20]) + j * 3072 + c0 + 4);
#pragma unroll
            for (int e = 0; e < 4; ++e) { w[j][e] = a0[e]; w[j][4 + e] = a1[e]; } }
        { const f32x4 a0 = *(const GAS f32x4*)((A->in[21]) + c0), a1 = *(const GAS f32x4*)((A->in[21]) + c0 + 4);
#pragma unroll
          for (int e = 0; e < 4; ++e) { bias[e] = a0[e]; bias[4 + e] = a1[e]; } }
        bf16* xout = ((bf16*)(A->ws + WS_XC)) + (size_t)t0 * 3072 + c0;
#pragma unroll
        for (int i = 0; i < 16; ++i) { float o[8];
#pragma unroll
            for (int e2 = 0; e2 < 4; ++e2) { float s0 = bias[2 * e2], s1 = bias[2 * e2 + 1];
#pragma unroll
                for (int j = 0; j < 5; ++j) { const unsigned r = raw[i + j][e2]; s0 += w[j][2 * e2] * bflo(r); s1 += w[j][2 * e2 + 1] * bfhi(r); }
                o[2 * e2] = silu_f(s0); o[2 * e2 + 1] = silu_f(s1); }
            *(GAS v4u*)(xout + (size_t)i * 3072) = (v4u){pkbf(o[0], o[1]), pkbf(o[2], o[3]), pkbf(o[4], o[5]), pkbf(o[6], o[7])}; }
    }
    for (int i = gt; i < MT * 64; i += NT) { const float x = ((float*)(A->ws + WS_DT))[i] + (A->in[23])[i & 63]; ((float*)(A->ws + WS_DT))[i] = fmaxf(x, 0.f) + log1pf(__expf(-fabsf(x))); }
}

__device__ __forceinline__ void chunk_scan(float a0, float a1, int lane, float& P0, float& P1, float& T) {
    P0 = wave_incl_scan(a0, lane); const float t0 = __shfl(P0, 63); P1 = wave_incl_scan(a1, lane) + t0; T = __shfl(P1, 63);
}

__device__ __forceinline__ void p5_states(Frame& F) {
    CArgs* A = ARGS_PTR(); int tid_ = (int)threadIdx.x; asm volatile("" : "+v"(tid_)); const int lane_ = tid_ & 63;
    LAS bf16* Bt = (LAS bf16*)(F.lds);
    LAS unsigned char* wbase = F.lds + 34816 + F.wave * 9728;
    LAS bf16* xw = (LAS bf16*)wbase;
    LAS float* wf = (LAS float*)(wbase + 8704); LAS float* wb = wf + 128;
    const int lane = lane_, q = lane >> 4, c = lane & 15;
    bf16* ST = (bf16*)(A->out + O_YS);
#pragma unroll 1
    for (int un = F.vcu; un < 192 * 4; un += F.G) {
        const int cs = un >> 2, g = un & 3, row0 = cs * 128, h = g * 8 + F.wave;
        for (int i = tid_; i < 2048; i += 512) { const int s = i >> 4, n8 = (i & 15) * 8;
            const v4u v = *(const GAS v4u*)(((bf16*)(A->ws + WS_XC)) + (size_t)(row0 + s) * 3072 + 2048 + g * 128 + n8);
            Bt[(n8 + 0) * 136 + s] = (bf16)(v.x & 0xffffu); Bt[(n8 + 1) * 136 + s] = (bf16)(v.x >> 16); Bt[(n8 + 2) * 136 + s] = (bf16)(v.y & 0xffffu); Bt[(n8 + 3) * 136 + s] = (bf16)(v.y >> 16);
            Bt[(n8 + 4) * 136 + s] = (bf16)(v.z & 0xffffu); Bt[(n8 + 5) * 136 + s] = (bf16)(v.z >> 16); Bt[(n8 + 6) * 136 + s] = (bf16)(v.w & 0xffffu); Bt[(n8 + 7) * 136 + s] = (bf16)(v.w >> 16); }
        {
            const float dtf0 = ((float*)(A->ws + WS_DT))[(size_t)(row0 + lane) * 64 + h], dtf1 = ((float*)(A->ws + WS_DT))[(size_t)(row0 + 64 + lane) * 64 + h];
            const float dtb0 = ((float*)(A->ws + WS_DT))[(size_t)(row0 + lane) * 64 + 32 + h], dtb1 = ((float*)(A->ws + WS_DT))[(size_t)(row0 + 64 + lane) * 64 + 32 + h];
            const float Af = -__expf((A->in[22])[h]), Ab = -__expf((A->in[22])[32 + h]);
            float P0, P1, T; chunk_scan(dtf0 * Af, dtf1 * Af, lane, P0, P1, T);
            wf[lane] = __expf(T - P0) * dtf0; wf[64 + lane] = __expf(T - P1) * dtf1;
            float Q0, Q1, Tb; chunk_scan(dtb0 * Ab, dtb1 * Ab, lane, Q0, Q1, Tb);
            wb[lane] = __expf(Q0 - dtb0 * Ab) * dtb0; wb[64 + lane] = __expf(Q1 - dtb1 * Ab) * dtb1;
            if (lane == 0) { ((float*)(A->ws + WS_DEC))[(cs * 2 + 0) * 32 + h] = __expf(T); ((float*)(A->ws + WS_DEC))[(cs * 2 + 1) * 32 + h] = __expf(Tb); }
        }
        __syncthreads();
#pragma unroll 1
        for (int ph = 0; ph < 2; ++ph) {
#pragma unroll
            for (int i = 0; i < 8; ++i) { const int s = i * 16 + (lane >> 2), pc = (lane & 3) * 8;
                const v4u v = *(const GAS v4u*)(((bf16*)(A->ws + WS_XC)) + (size_t)(row0 + s) * 3072 + h * 64 + ph * 32 + pc);
                LAS unsigned* d = (LAS unsigned*)(xw + s * 34 + pc); d[0] = v.x; d[1] = v.y; d[2] = v.z; d[3] = v.w; }
            LDS_WAIT();
#pragma unroll 1
            for (int d = 0; d < 2; ++d) {
                f32x4 acc[2][8];
#pragma unroll
                for (int mt = 0; mt < 2; ++mt)
#pragma unroll
                    for (int nt = 0; nt < 8; ++nt) acc[mt][nt] = (f32x4){0.f, 0.f, 0.f, 0.f};
                const LAS float* wd = d ? wb : wf;
#pragma unroll 1
                for (int ks = 0; ks < 4; ++ks) {
                    const int sb = ks * 32 + q * 8;
                    bf16x8 bfr[8];
#pragma unroll
                    for (int nt = 0; nt < 8; ++nt) bfr[nt] = *(const LAS bf16x8*)(Bt + (nt * 16 + c) * 136 + sb);
                    const f32x4 w0 = *(const LAS f32x4*)(wd + sb), w1 = *(const LAS f32x4*)(wd + sb + 4);
#pragma unroll
                    for (int mt = 0; mt < 2; ++mt) {
                        float xv[8];
#pragma unroll
                        for (int j = 0; j < 8; ++j) xv[j] = __uint_as_float(((unsigned)xw[(sb + j) * 34 + mt * 16 + c]) << 16);
                        v4u au; au.x = pkbf(xv[0] * w0[0], xv[1] * w0[1]); au.y = pkbf(xv[2] * w0[2], xv[3] * w0[3]);
                        au.z = pkbf(xv[4] * w1[0], xv[5] * w1[1]); au.w = pkbf(xv[6] * w1[2], xv[7] * w1[3]);
                        const bf16x8 afr = __builtin_bit_cast(bf16x8, au);
#pragma unroll
                        for (int nt = 0; nt < 8; ++nt) acc[mt][nt] = __builtin_amdgcn_mfma_f32_16x16x32_bf16(bfr[nt], afr, acc[mt][nt], 0, 0, 0);
                    }
                }
#pragma unroll
                for (int mt = 0; mt < 2; ++mt) { const int pp = ph * 32 + mt * 16 + c;
                    bf16* dst = ST + ((((size_t)cs * 2 + d) * 32 + h) * 64 + pp) * 128 + 4 * q;
#pragma unroll
                    for (int nt = 0; nt < 8; ++nt) *(GAS v2u*)(dst + nt * 16) = (v2u){pkbf(acc[mt][nt][0], acc[mt][nt][1]), pkbf(acc[mt][nt][2], acc[mt][nt][3])}; }
            }
        }
        __syncthreads();
    }
}
template <int NC, bool SAMP> __device__ __forceinline__ void p6_item(CArgs* A, int j) {
    const int n8 = (j & 15) * 8, p = (j >> 4) & 63, h = (j >> 10) & 31, dir = (j >> 15) & 1, b = j >> 16;
    const int cs0 = SAMP ? 64 + b * 32 : b * 2;
    bf16* ST = (bf16*)(A->out + O_YS); const float* DEC = (const float*)(A->ws + WS_DEC);
    v4u sv[NC]; float dec[NC]; float carry[8];
#pragma unroll
    for (int ci = 0; ci < NC; ++ci) { const int cs = cs0 + (dir ? NC - 1 - ci : ci);
        sv[ci] = *(const GAS v4u*)(ST + ((((size_t)cs * 2 + dir) * 32 + h) * 64 + p) * 128 + n8); dec[ci] = DEC[(cs * 2 + dir) * 32 + h]; }
    if (SAMP) { const float* init = (dir ? (A->in[6]) : (A->in[5])) + (((size_t)b * 32 + h) * 64 + p) * 128 + n8; const f32x4 a = *(const GAS f32x4*)init, bb = *(const GAS f32x4*)(init + 4);
#pragma unroll
        for (int e = 0; e < 4; ++e) { carry[e] = a[e]; carry[4 + e] = bb[e]; } }
    else {
#pragma unroll
        for (int e = 0; e < 8; ++e) carry[e] = 0.f; }
#pragma unroll
    for (int ci = 0; ci < NC; ++ci) { const int cs = cs0 + (dir ? NC - 1 - ci : ci);
        *(GAS v4u*)(ST + ((((size_t)cs * 2 + dir) * 32 + h) * 64 + p) * 128 + n8) = (v4u){pkbf(carry[0], carry[1]), pkbf(carry[2], carry[3]), pkbf(carry[4], carry[5]), pkbf(carry[6], carry[7])};
        const float d = dec[ci]; const v4u s = sv[ci];
        carry[0] = carry[0] * d + bflo(s.x); carry[1] = carry[1] * d + bfhi(s.x); carry[2] = carry[2] * d + bflo(s.y); carry[3] = carry[3] * d + bfhi(s.y);
        carry[4] = carry[4] * d + bflo(s.z); carry[5] = carry[5] * d + bfhi(s.z); carry[6] = carry[6] * d + bflo(s.w); carry[7] = carry[7] * d + bfhi(s.w); }
    if (!SAMP) { float* o = A->out + (dir ? O_SB : O_SF) + (((size_t)b * 32 + h) * 64 + p) * 128 + n8;
        *(GAS f32x4*)o = (f32x4){carry[0], carry[1], carry[2], carry[3]}; *(GAS f32x4*)(o + 4) = (f32x4){carry[4], carry[5], carry[6], carry[7]}; }
}
__device__ __forceinline__ void p6_scan(Frame& F) {
    CArgs* A = ARGS_PTR(); int tid_ = (int)threadIdx.x; asm volatile("" : "+v"(tid_));
    const int gt = F.vcu * 512 + tid_, NT = F.G * 512;
    constexpr int NS = 4 * 2 * 32 * 64 * 16, NP = 32 * 2 * 32 * 64 * 16;
#pragma unroll 1
    for (int idx = gt; idx < NS; idx += NT) p6_item<32, true>(A, idx);
#pragma unroll 1
    for (int idx = gt; idx < NP; idx += NT) p6_item<2, false>(A, idx);
}
__device__ __forceinline__ void p7_attention(Frame& F, char* lds_generic) {
    CArgs* A = ARGS_PTR(); int tid_ = (int)threadIdx.x; asm volatile("" : "+v"(tid_)); const int lane_ = tid_ & 63;
    float lam;
    {   const int l = lane_; const float d1 = (A->in[15])[l] * (A->in[16])[l] + (A->in[15])[64 + l] * (A->in[16])[64 + l], d2 = (A->in[17])[l] * (A->in[18])[l] + (A->in[17])[64 + l] * (A->in[18])[64 + l];
        lam = expf(wave_sum(d1)) - expf(wave_sum(d2)) + 0.2f; }
    float* scr = ((float*)(A->ws + WS_ASCR)) + (size_t)blockIdx.x * (128 * 512); bf16* CATb = (bf16*)(A->ws + WS_CAT); const float* gsub = A->in[19];
    constexpr int NU_S = 4 * 8 * 16, NU_P = 32 * 8;
#pragma unroll 1
    for (int un = F.vcu; un < NU_S + NU_P; un += F.G) {
        int qrow0, krow0, seq, h, t0 = 0; const bf16 *Kb, *Vb; const float* rtab = nullptr;
        if (un < NU_S) { const int qb = un & 15; h = (un >> 4) & 7; const int b = un >> 7; qrow0 = MP + b * 4096 + qb * 256; krow0 = b * KVS; seq = KVS; Kb = ((bf16*)(A->ws + WS_KS)); Vb = ((bf16*)(A->ws + WS_VS)); t0 = qb * 256; rtab = (const float*)(A->ws + WS_ROPE); }
        else { const int u2 = un - NU_S; h = u2 & 7; const int b = u2 >> 3; qrow0 = b * 256; krow0 = b * 256; seq = 256; Kb = ((bf16*)(A->ws + WS_KP)); Vb = ((bf16*)(A->ws + WS_VP)); }
        const bf16* Qp = ((bf16*)(A->ws + WS_Q)) + (size_t)qrow0 * 2048 + h * 256; const bf16* Kp = Kb + (size_t)krow0 * 2048 + h * 256; const bf16* Vp = Vb + (size_t)krow0 * 2048 + h * 256;
#pragma unroll 1
        for (int pp = 0; pp < (PROBE_DUP == 7 ? 4 : 2); ++pp) { const int pass = pp & 1;
            att2::attn_pass(pass, Qp + pass * 128, Kp + pass * 128, Vp, scr, CATb + (size_t)qrow0 * DM + h * 256, gsub, lam, seq, lds_generic, rtab, t0);
        }
    }
    asm volatile("s_waitcnt vmcnt(0) lgkmcnt(0)" ::: "memory"); __syncthreads();
}
typedef short s16x4 __attribute__((ext_vector_type(4)));
template <int OFF> __device__ __forceinline__ s16x4 p8_tr_read(int vb) { s16x4 r; asm volatile("ds_read_b64_tr_b16 %0, %1 offset:%2" : "=&v"(r) : "v"(vb), "i"(OFF) : "memory"); return r; }
constexpr int P8_CS = 0, P8_HA = 34816, P8_BUF = 51200, P8_BUFSZ = 55296, P8_PB = 17408, P8_XT = 34816, P8_XS = 80;
__device__ __forceinline__ void p8_ssd_out(Frame& F) {
    CArgs* A = ARGS_PTR(); int tid_ = (int)threadIdx.x; asm volatile("" : "+v"(tid_)); const int lane_ = tid_ & 63;
    LAS bf16* Cs = (LAS bf16*)(F.lds + P8_CS);
    LAS bf16* Bs = (LAS bf16*)(F.lds + P8_BUF + P8_BUFSZ);
    LAS float* HA = (LAS float*)(F.lds + P8_HA);
    const int lane = lane_, q = lane >> 4, c = lane & 15, w = F.wave;
    const bf16* XC = (const bf16*)(A->ws + WS_XC); const float* DT = (const float*)(A->ws + WS_DT); const bf16* ST = (const bf16*)(A->out + O_YS);
    const bf16* Zb = (const bf16*)(A->ws + WS_Z); bf16* CAT = (bf16*)(A->ws + WS_CAT);
    const int pr0 = tid_ >> 4, pn8 = (tid_ & 15) * 8;
    const int xs0 = tid_ >> 3, xp8 = (tid_ & 7) * 8;
#pragma unroll 1
    for (int un = F.vcu; un < 192 * 4; un += F.G) {
        const int cs = un >> 2, g = un & 3, row0 = cs * 128;
        v4u rpf[2], rpb[2], rx[2];
#define P8_LOADH(hl_) do { const int h_ = 8 * g + (hl_); const bf16* pf_ = ST + ((((size_t)cs * 2 + 0) * 32 + h_) * 64) * 128; const bf16* pb_ = pf_ + (size_t)32 * 64 * 128; \
            rpf[0] = *(const GAS v4u*)(pf_ + pr0 * 128 + pn8); rpf[1] = *(const GAS v4u*)(pf_ + (pr0 + 32) * 128 + pn8); \
            rpb[0] = *(const GAS v4u*)(pb_ + pr0 * 128 + pn8); rpb[1] = *(const GAS v4u*)(pb_ + (pr0 + 32) * 128 + pn8); \
            rx[0] = *(const GAS v4u*)(XC + (size_t)(row0 + xs0) * 3072 + h_ * 64 + xp8); rx[1] = *(const GAS v4u*)(XC + (size_t)(row0 + xs0 + 64) * 3072 + h_ * 64 + xp8); } while (0)
#define P8_STOREH(boff_) do { LAS unsigned char* b_ = F.lds + (boff_); \
            *(LAS v4u*)(b_ + (pr0 * 136 + pn8) * 2) = rpf[0]; *(LAS v4u*)(b_ + ((pr0 + 32) * 136 + pn8) * 2) = rpf[1]; \
            *(LAS v4u*)(b_ + P8_PB + (pr0 * 136 + pn8) * 2) = rpb[0]; *(LAS v4u*)(b_ + P8_PB + ((pr0 + 32) * 136 + pn8) * 2) = rpb[1]; \
            *(LAS v4u*)(b_ + P8_XT + (xs0 * P8_XS + xp8) * 2) = rx[0]; *(LAS v4u*)(b_ + P8_XT + ((xs0 + 64) * P8_XS + xp8) * 2) = rx[1]; } while (0)
        P8_LOADH(0);
        for (int i = tid_; i < 2048; i += 512) { const int s = i >> 4, n8 = (i & 15) * 8; const bf16* src = XC + (size_t)(row0 + s) * 3072 + 2048 + g * 128 + n8;
            *(LAS v4u*)(Bs + s * 136 + n8) = *(const GAS v4u*)src; *(LAS v4u*)(Cs + s * 136 + n8) = *(const GAS v4u*)(src + 512); }
        {   const int h = g * 8 + w; LAS float* ha = HA + w * 512; const float* al = A->in[22];
            const float dtf0 = DT[(size_t)(row0 + lane) * 64 + h], dtf1 = DT[(size_t)(row0 + 64 + lane) * 64 + h];
            const float dtb0 = DT[(size_t)(row0 + lane) * 64 + 32 + h], dtb1 = DT[(size_t)(row0 + 64 + lane) * 64 + 32 + h];
            const float Af = -__expf(al[h]), Ab = -__expf(al[32 + h]);
            float P0, P1, T; chunk_scan(dtf0 * Af, dtf1 * Af, lane, P0, P1, T);
            ha[lane] = P0; ha[64 + lane] = P1; ha[128 + lane] = dtf0; ha[192 + lane] = dtf1;
            float Q0, Q1, Tb; chunk_scan(dtb0 * Ab, dtb1 * Ab, lane, Q0, Q1, Tb);
            ha[256 + lane] = Tb - Q0 + dtb0 * Ab; ha[320 + lane] = Tb - Q1 + dtb1 * Ab; ha[384 + lane] = dtb0; ha[448 + lane] = dtb1; }
        P8_STOREH(P8_BUF);
        __syncthreads();
        f32x4 cbT[8];
#pragma unroll
        for (int st = 0; st < 8; ++st) cbT[st] = (f32x4){0.f, 0.f, 0.f, 0.f};
#pragma unroll
        for (int ks = 0; ks < 4; ++ks) { const bf16x8 cf = *(const LAS bf16x8*)(Cs + (16 * w + c) * 136 + ks * 32 + q * 8);
#pragma unroll
            for (int st = 0; st < 8; ++st) { const bf16x8 bf = *(const LAS bf16x8*)(Bs + (16 * st + c) * 136 + ks * 32 + q * 8);
                cbT[st] = __builtin_amdgcn_mfma_f32_16x16x32_bf16(bf, cf, cbT[st], 0, 0, 0); } }
        __syncthreads();
        const int l = 16 * w + c;
        float ssq = 0.f;
        bf16* orow = CAT + (size_t)(row0 + l) * DM + 2048 + g * 512;
#pragma unroll 1
        for (int hl = 0; hl < 8; ++hl) {
            const int h = 8 * g + hl, boff = P8_BUF + (hl & 1) * P8_BUFSZ;
            if (hl < 7) P8_LOADH(hl + 1);
            v2u zv[4];
#pragma unroll
            for (int pt = 0; pt < 4; ++pt) zv[pt] = *(const GAS v2u*)(Zb + (size_t)(row0 + l) * 2048 + h * 64 + 16 * pt + 4 * q);
            const LAS float* ha = HA + hl * 512; const LAS bf16* pfl = (const LAS bf16*)(F.lds + boff); const LAS bf16* pbl = (const LAS bf16*)(F.lds + boff + P8_PB); const LAS bf16* xt = (const LAS bf16*)(F.lds + boff + P8_XT);
            const float csf_l = ha[l], csb_l = ha[256 + l];
            f32x4 accD[4], accF[4], accB[4];
#pragma unroll
            for (int pt = 0; pt < 4; ++pt) { accD[pt] = (f32x4){0.f, 0.f, 0.f, 0.f}; accF[pt] = accD[pt]; accB[pt] = accD[pt]; }
            bf16x8 wfr[4];
#pragma unroll
            for (int u = 0; u < 4; ++u) {
                float wv[8];
#pragma unroll
                for (int half = 0; half < 2; ++half) { const int st = 2 * u + half, s4 = 16 * st + 4 * q;
                    if (st < w) { const f32x4 cs_s = *(const LAS f32x4*)(ha + s4), dt_s = *(const LAS f32x4*)(ha + 128 + s4);
#pragma unroll
                        for (int r = 0; r < 4; ++r) wv[half * 4 + r] = cbT[st][r] * (__expf(csf_l - cs_s[r]) * dt_s[r]); }
                    else if (st > w) { const f32x4 cs_s = *(const LAS f32x4*)(ha + 256 + s4), dt_s = *(const LAS f32x4*)(ha + 384 + s4);
#pragma unroll
                        for (int r = 0; r < 4; ++r) wv[half * 4 + r] = cbT[st][r] * (__expf(csb_l - cs_s[r]) * dt_s[r]); }
                    else { const f32x4 csf_s = *(const LAS f32x4*)(ha + s4), dtf_s = *(const LAS f32x4*)(ha + 128 + s4), csb_s = *(const LAS f32x4*)(ha + 256 + s4), dtb_s = *(const LAS f32x4*)(ha + 384 + s4);
#pragma unroll
                        for (int r = 0; r < 4; ++r) { const int s = s4 + r; const bool fw = s <= l;
                            const float e = __expf(fminf(fw ? csf_l - csf_s[r] : csb_l - csb_s[r], 0.f));
                            const float f = e * (fw ? dtf_s[r] : dtb_s[r]) + (s == l ? dtb_s[r] : 0.f);
                            wv[half * 4 + r] = cbT[st][r] * f; } }
                }
                v4u wu; wu.x = pkbf(wv[0], wv[1]); wu.y = pkbf(wv[2], wv[3]); wu.z = pkbf(wv[4], wv[5]); wu.w = pkbf(wv[6], wv[7]);
                wfr[u] = __builtin_bit_cast(bf16x8, wu);
            }
            {   const int vb = (int)(unsigned)(size_t)xt + (((4 * q + (c >> 2)) * P8_XS + 4 * (c & 3)) * 2);
#define P8_TR(u_, t_, pt_) p8_tr_read<((32 * (u_) + 16 * (t_)) * P8_XS + 16 * (pt_)) * 2>(vb)
#define P8_KSTEP(u_) do { const s16x4 a0 = P8_TR(u_, 0, 0), b0 = P8_TR(u_, 1, 0), a1 = P8_TR(u_, 0, 1), b1 = P8_TR(u_, 1, 1), a2 = P8_TR(u_, 0, 2), b2 = P8_TR(u_, 1, 2), a3 = P8_TR(u_, 0, 3), b3 = P8_TR(u_, 1, 3); \
                    asm volatile("s_waitcnt lgkmcnt(0)" ::: "memory"); __builtin_amdgcn_sched_barrier(0); \
                    accD[0] = __builtin_amdgcn_mfma_f32_16x16x32_bf16((bf16x8){a0[0], a0[1], a0[2], a0[3], b0[0], b0[1], b0[2], b0[3]}, wfr[u_], accD[0], 0, 0, 0); \
                    accD[1] = __builtin_amdgcn_mfma_f32_16x16x32_bf16((bf16x8){a1[0], a1[1], a1[2], a1[3], b1[0], b1[1], b1[2], b1[3]}, wfr[u_], accD[1], 0, 0, 0); \
                    accD[2] = __builtin_amdgcn_mfma_f32_16x16x32_bf16((bf16x8){a2[0], a2[1], a2[2], a2[3], b2[0], b2[1], b2[2], b2[3]}, wfr[u_], accD[2], 0, 0, 0); \
                    accD[3] = __builtin_amdgcn_mfma_f32_16x16x32_bf16((bf16x8){a3[0], a3[1], a3[2], a3[3], b3[0], b3[1], b3[2], b3[3]}, wfr[u_], accD[3], 0, 0, 0); } while (0)
                P8_KSTEP(0); P8_KSTEP(1); P8_KSTEP(2); P8_KSTEP(3);
#undef P8_KSTEP
#undef P8_TR
            }
#pragma unroll
            for (int ks = 0; ks < 4; ++ks) { const bf16x8 cf = *(const LAS bf16x8*)(Cs + (16 * w + c) * 136 + ks * 32 + q * 8);
#pragma unroll
                for (int pt = 0; pt < 4; ++pt) { const bf16x8 a = *(const LAS bf16x8*)(pfl + (16 * pt + c) * 136 + ks * 32 + q * 8), b = *(const LAS bf16x8*)(pbl + (16 * pt + c) * 136 + ks * 32 + q * 8);
                    accF[pt] = __builtin_amdgcn_mfma_f32_16x16x32_bf16(a, cf, accF[pt], 0, 0, 0); accB[pt] = __builtin_amdgcn_mfma_f32_16x16x32_bf16(b, cf, accB[pt], 0, 0, 0); } }
            const float ef = __expf(csf_l), eb = __expf(csb_l), dsk = (A->in[24])[h];
#pragma unroll
            for (int pt = 0; pt < 4; ++pt) { const int p0 = 16 * pt + 4 * q;
                const v2u xv = *(const LAS v2u*)(xt + l * P8_XS + p0);
                const float xs4[4] = {bflo(xv.x), bfhi(xv.x), bflo(xv.y), bfhi(xv.y)}, zs4[4] = {bflo(zv[pt].x), bfhi(zv[pt].x), bflo(zv[pt].y), bfhi(zv[pt].y)};
                float y[4];
#pragma unroll
                for (int r = 0; r < 4; ++r) { y[r] = (accD[pt][r] + ef * accF[pt][r] + eb * accB[pt][r] + dsk * xs4[r]) * (zs4[r] * __builtin_amdgcn_rcpf(1.f + __expf(-zs4[r]))); ssq += y[r] * y[r]; }
                *(GAS v2u*)(orow + hl * 64 + p0) = (v2u){pkbf(y[0], y[1]), pkbf(y[2], y[3])}; }
            if (hl < 7) P8_STOREH(P8_BUF + ((hl & 1) ^ 1) * P8_BUFSZ);
            __syncthreads();
        }
#undef P8_LOADH
#undef P8_STOREH
        ssq += __shfl_xor(ssq, 16); ssq += __shfl_xor(ssq, 32);
        const float rstd = 1.f / sqrtf(ssq * (1.f / 512.f) + RMS_EPS);
        if (q == 0) ((float*)(A->ws + WS_RST))[(size_t)(row0 + l) * 4 + g] = rstd;
    }
}
__device__ __forceinline__ void p9a_quant_cat(Frame& F) {
    CArgs* A = ARGS_PTR(); int tid_ = (int)threadIdx.x; asm volatile("" : "+v"(tid_)); const int lane = tid_ & 63;
    const int gw = F.vcu * NWAVES + F.wave, NGW = F.G * NWAVES;
    const bf16* CATb = (const bf16*)(A->ws + WS_CAT); unsigned char* CQ = (unsigned char*)(A->ws + WS_CATQ); float* SAC = (float*)(A->ws + WS_SAC);
    const float sg1 = (lane & 1) ? -1.f : 1.f, sg2 = (lane & 2) ? -1.f : 1.f, sg4 = (lane & 4) ? -1.f : 1.f;
    v4u vn[8];
    if (gw < MT) { const bf16* src = CATb + (size_t)gw * DM + 8 * lane;
#pragma unroll
        for (int j = 0; j < 8; ++j) vn[j] = *(const GAS v4u*)(src + j * 512); }
#pragma unroll 1
    for (int r = gw; r < MT; r += NGW) {
        unsigned char* dst = CQ + (size_t)r * DM + 8 * lane;
        v4u v[8]; float mx = 0.f;
#pragma unroll
        for (int j = 0; j < 8; ++j) v[j] = vn[j];
        const f32x4 rst = *(const GAS f32x4*)((const float*)(A->ws + WS_RST) + (size_t)r * 4);
        f32x4 gnv[4][2];
#pragma unroll
        for (int j = 0; j < 4; ++j) { const float* gn = (A->in[25]) + j * 512 + 8 * lane; gnv[j][0] = *(const GAS f32x4*)gn; gnv[j][1] = *(const GAS f32x4*)(gn + 4); }
        asm volatile("" ::: "memory");
        {   const int rn = r + NGW < MT ? r + NGW : MT - 1; const bf16* src = CATb + (size_t)rn * DM + 8 * lane;
#pragma unroll
            for (int j = 0; j < 8; ++j) vn[j] = *(const GAS v4u*)(src + j * 512); }
        float x[8][8];
#pragma unroll
        for (int j = 0; j < 8; ++j) {
#pragma unroll
            for (int e = 0; e < 4; ++e) { x[j][2 * e] = bflo(v[j][e]); x[j][2 * e + 1] = bfhi(v[j][e]); }
            if (j >= 4) { const f32x4 g0 = gnv[j - 4][0], g1 = gnv[j - 4][1]; const float rs = rst[j - 4];
#pragma unroll
                for (int e = 0; e < 4; ++e) { x[j][e] *= rs * g0[e]; x[j][4 + e] *= rs * g1[e]; } }
#pragma unroll
            for (int s = 1; s < 8; s <<= 1)
#pragma unroll
                for (int i = 0; i < 8; ++i) if (!(i & s)) { const float a = x[j][i], b = x[j][i | s]; x[j][i] = a + b; x[j][i | s] = a - b; }
#pragma unroll
            for (int i = 0; i < 8; ++i) {
                int iv = __builtin_bit_cast(int, x[j][i]);
                float v1 = fmaf(x[j][i], sg1, __builtin_bit_cast(float, __builtin_amdgcn_update_dpp(0, iv, 0xB1, 0xf, 0xf, true)));
                iv = __builtin_bit_cast(int, v1);
                float v2 = fmaf(v1, sg2, __builtin_bit_cast(float, __builtin_amdgcn_update_dpp(0, iv, 0x4E, 0xf, 0xf, true)));
                iv = __builtin_bit_cast(int, v2);
                int pr = __builtin_amdgcn_update_dpp(iv, iv, 0x104, 0xf, 0x5, false);
                pr = __builtin_amdgcn_update_dpp(pr, iv, 0x114, 0xf, 0xA, false);
                x[j][i] = fmaf(v2, sg4, __builtin_bit_cast(float, pr)); }
#pragma unroll
            for (int i = 0; i < 8; ++i) { x[j][i] *= 0.125f; mx = fmaxf(mx, fabsf(x[j][i])); } }
#pragma unroll
        for (int o = 1; o < 64; o <<= 1) mx = fmaxf(mx, __shfl_xor(mx, o));
        const float inv = mx > 0.f ? 127.f / mx : 0.f; if (lane == 0) SAC[r] = mx * (1.f / 127.f);
#pragma unroll
        for (int j = 0; j < 8; ++j) { unsigned o2[2];
#pragma unroll
            for (int h2 = 0; h2 < 2; ++h2) o2[h2] = Q4_MAGIC(x[j][4 * h2], x[j][4 * h2 + 1], x[j][4 * h2 + 2], x[j][4 * h2 + 3], inv);
            *(GAS v2u*)(dst + j * 512) = (v2u){o2[0], o2[1]}; }
    }
}
#define OPQ(T, name, expr) T name = (expr); asm volatile("" : "+s"(name))
__device__ __forceinline__ void p10_postmix(Frame& F) {
    CArgs* A = ARGS_PTR(); int tid_ = (int)threadIdx.x; asm volatile("" : "+v"(tid_)); const int lane_ = tid_ & 63;
    const int gw = F.vcu * NWAVES + F.wave, NGW = F.G * NWAVES, lane = lane_;
    const float* MODp = (const float*)(A->ws + WS_MOD); unsigned char* Hq = (unsigned char*)(A->ws + WS_H); float* SAHp = (float*)(A->ws + WS_SAH); const bf16* MIXb = (const bf16*)(A->ws + WS_MIX);
    const float* FOLDp = (const float*)(A->ws + WS_FOLD); bf16* X1b = (bf16*)(A->ws + WS_X1);
    LAS unsigned char* xl = F.lds + F.wave * 16384;
    LAS unsigned char* vst = F.lds + 131072;
    int cur_vi = -1;
#define P10_STAGE(vi_) do { __syncthreads(); \
        _Pragma("unroll") for (int i_ = 0; i_ < 6; ++i_) { const int p_ = tid_ + 512 * i_, v_ = p_ >> 10, c_ = (p_ & 1023) * 4; \
            const float* s_ = v_ == 0 ? FOLDp + (vi_) * 16384 + 4096 : (v_ == 1 ? FOLDp + (vi_) * 16384 + 8192 : MODp + (vi_) * 24576 + 12288); const f32x4 a_ = *(const GAS f32x4*)(s_ + c_); \
            *(LAS v2u*)(vst + v_ * 8192 + c_ * 2) = (v2u){pkbf(a_[0], a_[1]), pkbf(a_[2], a_[3])}; } \
        LDS_WAIT(); __syncthreads(); } while (0)
#define VEC8(dst0, dst1, voff_, j_) do { const v4u q_ = *(const LAS v4u*)(vst + (voff_) + (512 * (j_) + 8 * lane) * 2); \
        dst0 = (f32x4){bflo(q_[0]), bfhi(q_[0]), bflo(q_[1]), bfhi(q_[1])}; dst1 = (f32x4){bflo(q_[2]), bfhi(q_[2]), bflo(q_[3]), bfhi(q_[3])}; } while (0)
#define MLOAD(M, r_) do { OPQ(const bf16*, mr_, MIXb + (size_t)(r_) * DM); _Pragma("unroll") for (int j = 0; j < 8; ++j) M[j] = *(const GAS v4u*)(mr_ + 8 * lane + 512 * j); } while (0)
#define P10_BODY(M, MN, r_) do { const int rr_ = (r_); f32x4 X[16]; \
        const int vi_ = rr_ < MP ? 0 : 1 + ((rr_ - MP) >> 12); \
        if (vi_ != cur_vi) { P10_STAGE(vi_); cur_vi = vi_; } \
        VM_WAIT(); ROW_FROM_LDS8(X, xl); \
        { const int rn_ = rr_ + NGW; if (rn_ < MT) { ROW_PREFETCH(xl, XROW(rn_)); MLOAD(MN, rn_); } } \
        float ss_ = 0.f; \
        _Pragma("unroll") for (int j = 0; j < 8; ++j) { _Pragma("unroll") for (int e = 0; e < 4; ++e) { const float m0 = bflo(M[j][e]), m1 = bfhi(M[j][e]); ss_ += m0 * m0 + m1 * m1; } } \
        const float rstd_ = 1.f / sqrtf(wave_sum(ss_) * (1.f / DM) + RMS_EPS); float ss2_ = 0.f; \
        _Pragma("unroll") for (int jj = 0; jj < 4; ++jj) { OPQ(bf16*, oq_, X1b + (size_t)rr_ * DM + jj * 1024); \
            _Pragma("unroll") for (int j2 = 0; j2 < 2; ++j2) { const int col_ = 8 * lane + 512 * j2, j_ = 2 * jj + j2; f32x4 ga_[2]; VEC8(ga_[0], ga_[1], 0, j_); \
                _Pragma("unroll") for (int hh = 0; hh < 2; ++hh) { const int k_ = 2 * j_ + hh; \
                    const f32x4 mv_ = (f32x4){bflo(M[j_][2 * hh]), bfhi(M[j_][2 * hh]), bflo(M[j_][2 * hh + 1]), bfhi(M[j_][2 * hh + 1])}; \
                    X[k_] = X[k_] + ga_[hh] * (mv_ * rstd_); \
                    ss2_ += (X[k_][0] * X[k_][0] + X[k_][1] * X[k_][1]) + (X[k_][2] * X[k_][2] + X[k_][3] * X[k_][3]); } \
                *(GAS v4u*)(oq_ + col_) = (v4u){pkbf(X[2 * j_][0], X[2 * j_][1]), pkbf(X[2 * j_][2], X[2 * j_][3]), pkbf(X[2 * j_ + 1][0], X[2 * j_ + 1][1]), pkbf(X[2 * j_ + 1][2], X[2 * j_ + 1][3])}; } } \
        const float rstd2_ = 1.f / sqrtf(wave_sum(ss2_) * (1.f / DM) + RMS_EPS); float hm_ = 0.f; \
        _Pragma("unroll") for (int j_ = 0; j_ < 8; ++j_) { f32x4 sc_[2], sh_[2]; VEC8(sc_[0], sc_[1], 8192, j_); VEC8(sh_[0], sh_[1], 16384, j_); \
            _Pragma("unroll") for (int hh = 0; hh < 2; ++hh) { const int k_ = 2 * j_ + hh; \
                X[k_] = (X[k_] * rstd2_) * sc_[hh] + sh_[hh]; \
                hm_ = fmaxf(hm_, fmaxf(fmaxf(fabsf(X[k_][0]), fabsf(X[k_][1])), fmaxf(fabsf(X[k_][2]), fabsf(X[k_][3])))); } } \
        _Pragma("unroll") for (int o_ = 1; o_ < 64; o_ <<= 1) hm_ = fmaxf(hm_, __shfl_xor(hm_, o_)); \
          \
        const float hinv_ = hm_ > 0.f ? 127.f / hm_ : 0.f; if (lane == 0) SAHp[rr_] = hm_ * (1.f / 127.f); \
        { OPQ(unsigned char*, hq_, Hq + (size_t)rr_ * DM); \
            _Pragma("unroll") for (int j = 0; j < 8; ++j) { unsigned w2_[2]; \
                _Pragma("unroll") for (int hh = 0; hh < 2; ++hh) { const int k_ = 2 * j + hh; w2_[hh] = Q4_MAGIC(X[k_][0], X[k_][1], X[k_][2], X[k_][3], hinv_); } \
                *(GAS v2u*)(hq_ + 8 * lane + 512 * j) = (v2u){w2_[0], w2_[1]}; } } } while (0)
    v4u ma[8], mb[8];
    int r = gw; if (r < MT) { ROW_PREFETCH(xl, XROW(r)); MLOAD(ma, r); }
#pragma unroll 1
    for (; r < MT; r += 2 * NGW) { P10_BODY(ma, mb, r); if (r + NGW < MT) P10_BODY(mb, ma, r + NGW); }
#undef P10_BODY
#undef MLOAD
#undef VEC8
#undef P10_STAGE
}
__device__ __forceinline__ void p12_final(Frame& F) {
    CArgs* A = ARGS_PTR(); int tid_ = (int)threadIdx.x; asm volatile("" : "+v"(tid_)); const int lane_ = tid_ & 63;
    const int gw = F.vcu * NWAVES + F.wave, NGW = F.G * NWAVES, lane = lane_;
    const float* FOLDp = (const float*)(A->ws + WS_FOLD); const bf16* MO = (const bf16*)(A->ws + WS_MOUT); const bf16* X1b = (const bf16*)(A->ws + WS_X1); float* outp = A->out;
    LAS unsigned char* xl = F.lds + F.wave * 16384;
#define X1_PREFETCH(r_) do { const char* g_ = (const char*)(X1b + (size_t)(r_) * DM) + lane * 16; \
        _Pragma("unroll") for (int j = 0; j < 8; ++j) __builtin_amdgcn_global_load_lds((const unsigned*)(g_ + j * 1024), (LAS unsigned*)(xl + j * 1024), 16, 0, 0); } while (0)
#define MLOAD(M, r_) do { OPQ(const bf16*, mr_, MO + (size_t)(r_) * DM); _Pragma("unroll") for (int j = 0; j < 8; ++j) M[j] = *(const GAS v4u*)(mr_ + 8 * lane + 512 * j); } while (0)
    LAS unsigned char* vst = F.lds + 131072; int cur_vi = -1;
#define P12_STAGE(vi_) do { __syncthreads(); \
        _Pragma("unroll") for (int i_ = 0; i_ < 2; ++i_) { const int c_ = (tid_ + 512 * i_) * 4; *(LAS f32x4*)(vst + c_ * 4) = *(const GAS f32x4*)(FOLDp + (vi_) * 16384 + 12288 + c_); } \
        LDS_WAIT(); __syncthreads(); } while (0)
#define P12_BODY(M, MN, r_) do { const int rr_ = (r_); v4u X[8]; \
        const int vi_ = rr_ < MP ? 0 : 1 + ((rr_ - MP) >> 12); if (vi_ != cur_vi) { P12_STAGE(vi_); cur_vi = vi_; } \
        VM_WAIT(); _Pragma("unroll") for (int j = 0; j < 8; ++j) X[j] = *(const LAS v4u*)(xl + j * 1024 + lane * 16); LDS_WAIT(); \
        { const int rn_ = rr_ + NGW; if (rn_ < MT) { X1_PREFETCH(rn_); MLOAD(MN, rn_); } } \
        float ss_ = 0.f; \
        _Pragma("unroll") for (int j = 0; j < 8; ++j) { _Pragma("unroll") for (int e = 0; e < 4; ++e) { const float m0 = bflo(M[j][e]), m1 = bfhi(M[j][e]); ss_ += m0 * m0 + m1 * m1; } } \
        const float rstd_ = 1.f / sqrtf(wave_sum(ss_) * (1.f / DM) + RMS_EPS); \
        _Pragma("unroll") for (int jj = 0; jj < 4; ++jj) { OPQ(float*, oq_, outp + (size_t)rr_ * DM + jj * 1024); \
            _Pragma("unroll") for (int j2 = 0; j2 < 2; ++j2) { const int col_ = 8 * lane + 512 * j2, k_ = 2 * jj + j2; \
                _Pragma("unroll") for (int hh = 0; hh < 2; ++hh) { \
                    const f32x4 gm_ = *(const LAS f32x4*)(vst + (jj * 1024 + col_ + 4 * hh) * 4); \
                    const f32x4 mv_ = (f32x4){bflo(M[k_][2 * hh]), bfhi(M[k_][2 * hh]), bflo(M[k_][2 * hh + 1]), bfhi(M[k_][2 * hh + 1])}; \
                    const f32x4 xv_ = (f32x4){bflo(X[k_][2 * hh]), bfhi(X[k_][2 * hh]), bflo(X[k_][2 * hh + 1]), bfhi(X[k_][2 * hh + 1])}; \
                    *(GAS f32x4*)(oq_ + col_ + 4 * hh) = xv_ + gm_ * (mv_ * rstd_); } } } } while (0)
    v4u ma[8], mb[8];
    int r = gw; if (r < MT) { X1_PREFETCH(r); MLOAD(ma, r); }
#pragma unroll 1
    for (; r < MT; r += 2 * NGW) { P12_BODY(ma, mb, r); if (r + NGW < MT) P12_BODY(mb, ma, r + NGW); }
#undef P12_BODY
#undef P12_STAGE
#undef MLOAD
#undef X1_PREFETCH
#undef XROW
}

constexpr int N_PHASES = 13;

__global__ void __launch_bounds__(NWAVES * 64, 2) hymba_fwd(Args args) {
    extern __shared__ __attribute__((aligned(16))) unsigned char lds[];
    Frame F;
    F.lds = (LAS unsigned char*)lds;
    F.tid = threadIdx.x; F.lane = F.tid & 63; F.wave = __builtin_amdgcn_readfirstlane(F.tid >> 6);
    F.G = gridDim.x; { const int bx = blockIdx.x; F.vcu = (F.G % 8 == 0) ? (bx % 8) * (F.G / 8) + bx / 8 : bx; }
    unsigned* const ctl = (unsigned*)(args.ws + WS_CTL);
    for (int u = F.tid; u < (LDS_BYTES - LDSCTL_OFF) / 4; u += NWAVES * 64) ((LAS unsigned*)(F.lds + LDSCTL_OFF))[u] = 0u;
    __syncthreads();
    XcdBarrier bar = xcd_barrier_post(ctl + CW_BAR, (volatile LAS unsigned*)(F.lds + MISC_OFF) + 8);
    const int lo = args.ph_lo, hi = args.ph_hi;
#ifndef ONLY_PHASE
#define ONLY_PHASE -1
#endif
#define IN(k) ((ONLY_PHASE < 0 || ONLY_PHASE == (k)) && lo <= (k) && (k) < hi)
#define SEAM(k) do { if (IN(k) && IN((k) + 1)) xcd_barrier(bar); } while (0)
#ifndef PROBE_MASK
#define PROBE_MASK 0
#endif
#define NREP(k) (((PROBE_DUP == (k)) || ((PROBE_MASK >> (k)) & 1)) ? 2 : 1)

    for (int rep = 0; rep < NREP(0); ++rep) { if (rep) xcd_barrier(bar); if (IN(0)) p0_prologue(F); }
    SEAM(0);
    for (int rep = 0; rep < NREP(1); ++rep) { if (rep) xcd_barrier(bar); if (IN(1)) p1_mod(F); }
    SEAM(1);
    for (int rep = 0; rep < NREP(2); ++rep) { if (rep) xcd_barrier(bar); if (IN(2)) p2_h(F); }
    SEAM(2);
    for (int rep = 0; rep < NREP(3); ++rep) { if (rep) xcd_barrier(bar);
    if (IN(3)) {
#define EPI_IN(pn0_, row0_) pg8::EpiIn{((bf16*)(args.ws + WS_KP)), ((bf16*)(args.ws + WS_KS)), ((bf16*)(args.ws + WS_VP)), ((bf16*)(args.ws + WS_VS)), ((bf16*)(args.ws + WS_XR)), ((float*)(args.ws + WS_DT)), (args.out) + O_NK, (args.out) + O_NV, pn0_, row0_}
        {   pg8::Gemm g{((bf16*)(args.ws + WS_H)), ((bf16*)(args.ws + WS_WIN)), MP, NINB, DM}; pg8::StaticOrder S; S.init(MP, NINB, F.G, (int)blockIdx.x);
            pg8::EpiIn E = EPI_IN(0, 0); pg8::gemm_phase<pg8::EpiIn, pg8::StaticOrder, true, true>(F.lds, g, S, E); }
        {   pg8::Gemm g{((bf16*)(args.ws + WS_H)) + (size_t)MP * DM, ((bf16*)(args.ws + WS_WIN)) + (size_t)7168 * DM, MS, 256, DM}; pg8::StaticOrder S; S.init(MS, 256, F.G, (int)(F.G - 1 - blockIdx.x));
            pg8::EpiIn E = EPI_IN(28, MP); pg8::gemm_phase<pg8::EpiIn, pg8::StaticOrder, true, true>(F.lds, g, S, E); }
#undef EPI_IN
        {   pg8::Gemm g{(const pg8::bf16_t*)(args.ws + WS_HQ), (const pg8::bf16_t*)(args.ws + WS_WINQ), MT, DM, DM / 2}; pg8::StaticOrder S; S.init(MT, DM, F.G, (int)(F.G - 1 - blockIdx.x));
            pg8::EpiQZ E{((bf16*)(args.ws + WS_Q)), ((bf16*)(args.ws + WS_Z)), (const float*)(args.ws + WS_SAHI), (const float*)(args.ws + WS_SBI)};
            pg8::gemm_phase_i8<pg8::EpiQZ, pg8::StaticOrder, true, true>(F.lds, g, S, E); }
        {   pg8::Gemm g{(const pg8::bf16_t*)(args.ws + WS_HQ + (size_t)MP * DM), (const pg8::bf16_t*)(args.ws + WS_WINQ + (size_t)4096 * DM), MS, DM, DM / 2}; pg8::StaticOrder S; S.init(MS, DM, F.G, (int)blockIdx.x);
            pg8::EpiKVs E{((bf16*)(args.ws + WS_KS)), ((bf16*)(args.ws + WS_VS)), (const float*)(args.ws + WS_SAHI) + MP, (const float*)(args.ws + WS_SBI) + 4096};
            pg8::gemm_phase_i8<pg8::EpiKVs, pg8::StaticOrder, true, true>(F.lds, g, S, E); }
        {   pg8::Gemm g{(const pg8::bf16_t*)(args.ws + WS_HQ + (size_t)MP * DM), (const pg8::bf16_t*)(args.ws + WS_WINQ + (size_t)8192 * DM), MS, 3072, DM / 2}; pg8::StaticOrder S; S.init(MS, 3072, F.G, (int)blockIdx.x);
            pg8::EpiXs E{((bf16*)(args.ws + WS_XR)) + (size_t)MP * 3072, (const float*)(args.ws + WS_SAHI) + MP, (const float*)(args.ws + WS_SBI) + 8192};
            pg8::gemm_phase_i8<pg8::EpiXs, pg8::StaticOrder, true, true>(F.lds, g, S, E); }
    } }
    SEAM(3);
    if (IN(4)) p4_rope_conv(F);
    SEAM(4);
    for (int rep = 0; rep < NREP(5); ++rep) { if (rep) xcd_barrier(bar); if (IN(5)) p5_states(F); }
    SEAM(5);
    if (IN(6)) { p6_scan(F); }
    if (IN(7)) { __syncthreads(); p7_attention(F, (char*)lds); }
    SEAM(7);
    for (int rep = 0; rep < NREP(8); ++rep) { if (rep) xcd_barrier(bar); if (IN(8)) p8_ssd_out(F); }
    SEAM(8);
    if (IN(9)) {
        p9a_quant_cat(F);
        xcd_barrier(bar);
        pg8::Gemm g{(const pg8::bf16_t*)(args.ws + WS_CATQ), (const pg8::bf16_t*)(args.ws + WS_WOUTQ), MT, DM, DM / 2}; pg8::StaticOrder S; S.init(MT, DM, F.G, (int)blockIdx.x);
        pg8::EpiMixI8 E{((bf16*)(args.ws + WS_MIX)), DM, (const float*)(args.ws + WS_SAC), (const float*)(args.ws + WS_SBO)};
        pg8::gemm_phase_i8<pg8::EpiMixI8, pg8::StaticOrder, true, true>(F.lds, g, S, E);
    }
    SEAM(9);
    for (int rep = 0; rep < NREP(10); ++rep) { if (rep) xcd_barrier(bar); if (IN(10)) p10_postmix(F); }
    SEAM(10);
    for (int rep = 0; rep < NREP(11); ++rep) { if (rep) xcd_barrier(bar);
    if (IN(11)) {
#pragma unroll 1
        for (int step = 0; step <= N_MLP_CH; ++step) {
            if (step > 0) { const int ch = step - 1;
                pg8::Gemm g{(const pg8::bf16_t*)(args.ws + WS_UPQ), (const pg8::bf16_t*)(args.ws + WS_WDN), MLP_CH, DM, DFF / 2}; pg8::StaticOrder S; S.init(MLP_CH, DM, F.G, (int)blockIdx.x);
                pg8::EpiDownI8 E{((bf16*)(args.ws + WS_MOUT)) + (size_t)ch * MLP_CH * DM, DM, (const float*)(args.ws + WS_SA) + ch * MLP_CH, (const float*)(args.ws + WS_SB), (const int*)(args.ws + WS_CTL) + CW_CS};
                pg8::gemm_phase_i8<pg8::EpiDownI8, pg8::StaticOrder, true, true>(F.lds, g, S, E); }
            if (step < N_MLP_CH) {
                {   pg8::Gemm g{(const pg8::bf16_t*)(args.ws + WS_H + (size_t)step * MLP_CH * DM), (const pg8::bf16_t*)(args.ws + WS_WUP), MLP_CH, DFF, DM / 2}; pg8::StaticOrder S; S.init(MLP_CH, DFF, F.G, (int)blockIdx.x);
                    pg8::EpiUpI8L E{(unsigned char*)(args.ws + WS_UPQ), DFF, (float*)(args.ws + WS_UP), (const float*)(args.ws + WS_SAH) + step * MLP_CH, (const float*)(args.ws + WS_SBU)};
                    pg8::gemm_phase_i8<pg8::EpiUpI8L, pg8::StaticOrder, true, true>(F.lds, g, S, E); }
                xcd_barrier(bar);
                p11_requant(F, step, (unsigned char*)(args.ws + WS_UPQ), (const float*)(args.ws + WS_UP));
                xcd_barrier(bar); }
        }
    } }
    SEAM(11);
    if (IN(12)) p12_final(F);
#undef IN
#undef SEAM
}

extern "C" void kernel_launch(void* const* d_in, const int* in_sizes, int n_in, void* d_out, int out_size, void* d_ws, size_t ws_size, hipStream_t stream) {
    static int grid = 0;
    if (grid == 0) {
        if (n_in != 29 || (size_t)out_size != OUT_TOTAL || ws_size < WS_END) { fprintf(stderr, "kernel_launch: unexpected shapes: n_in %d out %d ws %zu (need %zu)\n", n_in, out_size, ws_size, (size_t)WS_END); grid = -1; return; }
        int dev = 0, cus = 0;
        if (hipGetDevice(&dev) != hipSuccess || hipDeviceGetAttribute(&cus, hipDeviceAttributeMultiprocessorCount, dev) != hipSuccess) { grid = -1; return; }
        if (hipFuncSetAttribute((const void*)hymba_fwd, hipFuncAttributeMaxDynamicSharedMemorySize, LDS_BYTES) != hipSuccess) { fprintf(stderr, "kernel_launch: hipFuncSetAttribute failed\n"); grid = -1; return; }
        int per_cu = 0;
        if (hipOccupancyMaxActiveBlocksPerMultiprocessor(&per_cu, (const void*)hymba_fwd, NWAVES * 64, LDS_BYTES) != hipSuccess || per_cu < 1) fprintf(stderr, "kernel_launch: occupancy query says %d\n", per_cu);
        (void)hipGetLastError();
        grid = cus;
    }
    if (grid < 0) return;
    if (hipMemsetAsync((char*)d_ws + WS_CTL, 0, CTL_ZERO_BYTES, stream) != hipSuccess) return;
    Args a{};
    for (int i = 0; i < 29; ++i) a.in[i] = (const float*)d_in[i];
    a.out = (float*)d_out; a.ws = (unsigned char*)d_ws; a.ph_lo = 0; a.ph_hi = N_PHASES;
    hipLaunchKernelGGL(hymba_fwd, dim3(grid), dim3(NWAVES * 64), LDS_BYTES, stream, a);
    const hipError_t le = hipPeekAtLastError();
    if (le != hipSuccess) fprintf(stderr, "kernel_launch: launch failed: %s\n", hipGetErrorName(le));
}
```

```cpp
#include <hip/hip_runtime.h>
#include <cstdio>

namespace pg8 {
#define PG8_LAS __attribute__((address_space(3)))
typedef unsigned short bf16_t;
typedef short bf16x8 __attribute__((ext_vector_type(8)));
typedef float f32x4 __attribute__((ext_vector_type(4)));
typedef unsigned u32x4 __attribute__((ext_vector_type(4)));
typedef int i32x4 __attribute__((ext_vector_type(4)));
constexpr int BM = 256, BK = 64, HALF = 128, HTB = HALF * BK * 2  , STAGE_BYTES = 8 * HTB, NXCD = 8, WGM = 8;

__host__ __device__ __forceinline__ int lds_byte(int r, int c) { const int st = (r >> 4) * 2 + (c >> 5), rr = r & 15, cc = c & 31, ob = rr * 64 + cc * 2; return st * 1024 + (ob ^ (((ob >> 9) & 1) << 5)); }
__host__ __device__ __forceinline__ void stage_rc(int b, int& R, int& C) { const int st = b / 1024, sb = b % 1024, swz = sb ^ (((sb >> 9) & 1) << 5); R = (st >> 1) * 16 + swz / 64; C = (st & 1) * 32 + (swz % 64) / 2; }
__host__ __device__ __forceinline__ int perm32(int rho) { const int n = rho >> 4, i = rho & 15; return 8 * (i >> 2) + 4 * n + (i & 3); }

struct Unit { int pm, pn; };
struct Gemm { const bf16_t* A; const bf16_t* Bt; int M, N, K; };

struct StaticOrder {
    int nM, nN, nwg, G, c;
    __host__ __device__ void init(int M, int N, int G_, int c_) { nM = M / BM; nN = N / BM; nwg = nM * nN; G = G_; c = c_; }
    __host__ __device__ bool next(int i, Unit& u) const {
        const long L = (long)i * G + c; if (L >= nwg) return false;
        int wgid = (int)L; { const int q = nwg / NXCD, r = nwg % NXCD, xcd = wgid % NXCD, off = wgid / NXCD; wgid = (xcd < r ? xcd * (q + 1) : r * (q + 1) + (xcd - r) * q) + off; }
        const int nig = WGM * nN, gid = wgid / nig, fm = gid * WGM, gsz = (nM - fm) < WGM ? (nM - fm) : WGM;
        u.pm = fm + ((wgid % nig) % gsz); u.pn = (wgid % nig) / gsz; return true;
    }
    __device__ __forceinline__ void a_ready(const Unit&) const {}
    __device__ __forceinline__ void done(const Unit&) const {}
};

__device__ __forceinline__ unsigned cvt_pk_bf16(float lo, float hi) { unsigned r; asm volatile("v_cvt_pk_bf16_f32 %0, %1, %2" : "=v"(r) : "v"(lo), "v"(hi)); return r; }
typedef float f32x2 __attribute__((ext_vector_type(2)));
__device__ __forceinline__ f32x2 gelu_pk(f32x2 v) {
    const f32x2 av = __builtin_elementwise_abs(v), d = av * 0.2316418882f + 1.0f;
    f32x2 t; t.x = __builtin_amdgcn_rcpf(d.x); t.y = __builtin_amdgcn_rcpf(d.y);
    f32x2 q = t * 0.5307027145f + (-0.7265760135f); q = q * t + 0.7107068705f; q = q * t + (-0.142248368f); q = q * t + 0.127414796f; q = q * t;
    const f32x2 s = (v * v) * (-0.72134752044f);
    f32x2 e; e.x = __builtin_amdgcn_exp2f(s.x); e.y = __builtin_amdgcn_exp2f(s.y);
    const f32x2 m = v * (q * e), r = v - m;
    f32x2 o; o.x = v.x < 0.f ? m.x : r.x; o.y = v.y < 0.f ? m.y : r.y; return o;
}

template <int ACT  > struct EpiBf16 {
    static constexpr bool PERM = true, AFTER_DRAIN = false; static_assert(ACT == 0 || ACT == 1, "EpiBf16: ACT is 0 (none) or 1 (gelu_pk)");
    bf16_t* O; int ldc; const float* bias; int split_cols; size_t split_stride; float scale0;
    __device__ __forceinline__ void operator()(const f32x4 (&acc)[2][2][4][2], const Unit& u, int wr, int wc, int fr, int fq) const {
        const int row0 = u.pm * BM + wr * 64 + fr; int colt = u.pn * BM; bf16_t* base = O;
        float sc = 1.f; if (split_cols) { const int t = colt / split_cols; base += (size_t)t * split_stride; colt -= t * split_cols; if (t == 0) sc = scale0; }
        const int col0 = colt + wc * 32 + 8 * fq, bcol0 = u.pn * BM + wc * 32 + 8 * fq;
        f32x4 bv[2][2];
#pragma unroll
        for (int bj = 0; bj < 2; ++bj)
#pragma unroll
            for (int n = 0; n < 2; ++n) bv[bj][n] = bias ? *(const f32x4*)(bias + bcol0 + bj * HALF + 4 * n) : (f32x4){0.f, 0.f, 0.f, 0.f};
#pragma unroll
        for (int ai = 0; ai < 2; ++ai)
#pragma unroll
            for (int m = 0; m < 4; ++m) { bf16_t* rowp = base + (size_t)(row0 + ai * HALF + m * 16) * ldc + col0;
#pragma unroll
                for (int bj = 0; bj < 2; ++bj) { f32x4 v0 = acc[ai][bj][m][0] + bv[bj][0], v1 = acc[ai][bj][m][1] + bv[bj][1];
                    if (ACT == 1) { f32x2 a = gelu_pk((f32x2){v0[0], v0[1]}), b = gelu_pk((f32x2){v0[2], v0[3]}), c = gelu_pk((f32x2){v1[0], v1[1]}), d = gelu_pk((f32x2){v1[2], v1[3]});
                        v0 = (f32x4){a.x, a.y, b.x, b.y}; v1 = (f32x4){c.x, c.y, d.x, d.y}; }
                    v0 = v0 * sc; v1 = v1 * sc; u32x4 w; w.x = cvt_pk_bf16(v0[0], v0[1]); w.y = cvt_pk_bf16(v0[2], v0[3]); w.z = cvt_pk_bf16(v1[0], v1[1]); w.w = cvt_pk_bf16(v1[2], v1[3]);
                    *(u32x4*)(rowp + bj * HALF) = w; } }
    }
};
template <class Epi, class Sched, bool ALIGN_EPI = false, bool SP2 = false>
__device__ __forceinline__ void gemm_phase(PG8_LAS unsigned char* lds, const Gemm g, const Sched& S, const Epi& E) {
    int tid = threadIdx.x; asm volatile("" : "+v"(tid));
    const int wid = __builtin_amdgcn_readfirstlane(tid >> 6), lane = tid & 63, wr = wid >> 2, wc = wid & 3, fr = lane & 15, fq = lane >> 4;
    const int K = g.K, nt = K / BK;
    unsigned voffA[2], voffB[2];
#pragma unroll
    for (int i = 0; i < 2; ++i) { int R, C; stage_rc(tid * 16 + i * 8192, R, C); const int Rb = Epi::PERM ? ((R & ~31) + perm32(R & 31)) : R;
        voffA[i] = (unsigned)(R * K + C) * 2u; voffB[i] = (unsigned)(Rb * K + C) * 2u; }
    const size_t kstep = (size_t)(BK * 2);
    const size_t hstep = (size_t)HALF * K * 2;
    const size_t tstep = 2 * hstep;
    const unsigned ldsw = (unsigned)wid * 1024u;
    const int aoff = lds_byte(wr * 64 + fr, fq * 8), boff = lds_byte(wc * 32 + fr, fq * 8);
#define PG8_SA(b, h) (((b) * 2 + (h)) * HTB)
#define PG8_SB(b, h) ((4 + (b) * 2 + (h)) * HTB)
#define PG8_STAGE(bufoff, gbase, voff) do { _Pragma("unroll") for (int _i = 0; _i < 2; ++_i) \
        __builtin_amdgcn_global_load_lds((const unsigned*)((const char*)(gbase) + (voff)[_i]), (PG8_LAS unsigned*)(lds + (bufoff) + ldsw + _i * 8192), 16, 0, 0); } while (0)
#define PG8_LDA(dst, b, h) do { _Pragma("unroll") for (int m = 0; m < 4; ++m) _Pragma("unroll") for (int k = 0; k < 2; ++k) dst[m][k] = *(const PG8_LAS bf16x8*)(lds + PG8_SA(b, h) + aoff + m * 2048 + k * 1024); } while (0)
#define PG8_LDB(dst, b, h) do { _Pragma("unroll") for (int n = 0; n < 2; ++n) _Pragma("unroll") for (int k = 0; k < 2; ++k) dst[n][k] = *(const PG8_LAS bf16x8*)(lds + PG8_SB(b, h) + boff + n * 2048 + k * 1024); } while (0)
#define PG8_MMA(ai, bj, At, Bt) do { __builtin_amdgcn_s_setprio(1); _Pragma("unroll") for (int m = 0; m < 4; ++m) _Pragma("unroll") for (int n = 0; n < 2; ++n) _Pragma("unroll") for (int k = 0; k < 2; ++k) \
        acc[ai][bj][m][n] = __builtin_amdgcn_mfma_f32_16x16x32_bf16(Bt[n][k], At[m][k], acc[ai][bj][m][n], 0, 0, 0); __builtin_amdgcn_s_setprio(0); } while (0)
#define PG8_WAIT_V(n) asm volatile("s_waitcnt vmcnt(" #n ")" ::: "memory")
#define PG8_WAIT_L(n) asm volatile("s_waitcnt lgkmcnt(" #n ")" ::: "memory")
#define PG8_BAR __builtin_amdgcn_s_barrier()
#define PG8_SCHED __builtin_amdgcn_sched_barrier(0)
    Unit cur, nxt; int ui = 0;
    if (!S.next(0, cur)) return;
    f32x4 acc[2][2][4][2];
#pragma unroll
    for (int a = 0; a < 2; ++a)
#pragma unroll
        for (int b = 0; b < 2; ++b)
#pragma unroll
            for (int m = 0; m < 4; ++m)
#pragma unroll
                for (int n = 0; n < 2; ++n) acc[a][b][m][n] = (f32x4){0.f, 0.f, 0.f, 0.f};
    bf16x8 At[4][2], B0[2][2], B1[2][2];
    const char* cA = (const char*)g.A + (size_t)cur.pm * tstep; const char* cB = (const char*)g.Bt + (size_t)cur.pn * tstep;
    S.a_ready(cur);
    if constexpr (SP2) {
        PG8_STAGE(PG8_SB(0, 0), cB, voffB); PG8_STAGE(PG8_SB(0, 1), cB + hstep, voffB); PG8_STAGE(PG8_SA(0, 0), cA, voffA); PG8_STAGE(PG8_SA(0, 1), cA + hstep, voffA);
        if (wr == 1) PG8_BAR;
        PG8_WAIT_V(2); PG8_BAR;
        PG8_STAGE(PG8_SB(1, 0), cB + kstep, voffB); PG8_STAGE(PG8_SA(1, 0), cA + kstep, voffA); PG8_STAGE(PG8_SB(1, 1), cB + hstep + kstep, voffB);
        PG8_WAIT_V(6); PG8_BAR;
    } else {
        PG8_STAGE(PG8_SB(0, 0), cB, voffB); PG8_STAGE(PG8_SA(0, 0), cA, voffA); PG8_STAGE(PG8_SB(0, 1), cB + hstep, voffB); PG8_STAGE(PG8_SA(0, 1), cA + hstep, voffA);
        if (wr == 1) PG8_BAR;
        PG8_WAIT_V(4); PG8_BAR;
        PG8_STAGE(PG8_SB(1, 0), cB + kstep, voffB); PG8_STAGE(PG8_SA(1, 0), cA + kstep, voffA); PG8_STAGE(PG8_SB(1, 1), cB + hstep + kstep, voffB);
        PG8_WAIT_V(6); PG8_BAR;
    }
    for (;;) {
        const bool has_next = S.next(ui + 1, nxt);
        const char* nA = has_next ? (const char*)g.A + (size_t)nxt.pm * tstep : cA; const char* nB = has_next ? (const char*)g.Bt + (size_t)nxt.pn * tstep : cB;
        for (int t = 0; t < nt; t += 2) {
            const bool last = (t == nt - 2);
            const char* a1 = cA + (size_t)(t + 1) * kstep;
            const char* a2 = last ? nA : cA + (size_t)(t + 2) * kstep; const char* b2 = last ? nB : cB + (size_t)(t + 2) * kstep;
            const char* a3 = a2 + kstep; const char* b3 = b2 + kstep;
            if (last && has_next) S.a_ready(nxt);
            if constexpr (SP2) {
            PG8_LDB(B0, 0, 0); PG8_LDB(B1, 0, 1); PG8_SCHED; PG8_LDA(At, 0, 0); PG8_STAGE(PG8_SA(1, 1), a1 + hstep, voffA);
            PG8_WAIT_V(8); PG8_WAIT_L(0); PG8_BAR; PG8_MMA(0, 0, At, B0); PG8_MMA(0, 1, At, B1); PG8_BAR; PG8_SCHED;
            PG8_LDA(At, 0, 1); PG8_STAGE(PG8_SB(0, 0), b2, voffB); PG8_STAGE(PG8_SB(0, 1), b2 + hstep, voffB); PG8_STAGE(PG8_SA(0, 0), a2, voffA);
            PG8_WAIT_V(8); PG8_WAIT_L(0); PG8_BAR; PG8_MMA(1, 0, At, B0); PG8_MMA(1, 1, At, B1); PG8_BAR; PG8_SCHED;
            PG8_LDB(B0, 1, 0); PG8_LDB(B1, 1, 1); PG8_SCHED; PG8_LDA(At, 1, 0); PG8_STAGE(PG8_SA(0, 1), a2 + hstep, voffA);
            PG8_WAIT_V(8); PG8_WAIT_L(0); PG8_BAR; PG8_MMA(0, 0, At, B0); PG8_MMA(0, 1, At, B1); PG8_BAR; PG8_SCHED;
            PG8_LDA(At, 1, 1); PG8_STAGE(PG8_SB(1, 0), b3, voffB); PG8_STAGE(PG8_SB(1, 1), b3 + hstep, voffB); PG8_STAGE(PG8_SA(1, 0), a3, voffA);
            PG8_WAIT_V(8); PG8_WAIT_L(0); PG8_BAR; PG8_MMA(1, 0, At, B0); PG8_MMA(1, 1, At, B1); PG8_BAR; PG8_SCHED;
            } else {
            PG8_LDB(B0, 0, 0); PG8_SCHED; PG8_LDA(At, 0, 0); PG8_STAGE(PG8_SA(1, 1), a1 + hstep, voffA);
            PG8_WAIT_L(8); PG8_BAR; PG8_WAIT_L(0); PG8_MMA(0, 0, At, B0); PG8_BAR; PG8_SCHED;
            PG8_LDB(B1, 0, 1); PG8_STAGE(PG8_SB(0, 0), b2, voffB);
            PG8_BAR; PG8_WAIT_L(0); PG8_MMA(0, 1, At, B1); PG8_BAR;
            PG8_LDA(At, 0, 1); PG8_STAGE(PG8_SA(0, 0), a2, voffA);
            PG8_BAR; PG8_WAIT_L(0); PG8_MMA(1, 0, At, B0); PG8_BAR; PG8_SCHED;
            PG8_STAGE(PG8_SB(0, 1), b2 + hstep, voffB);
            PG8_WAIT_V(6); PG8_BAR; PG8_MMA(1, 1, At, B1); PG8_BAR;
            PG8_LDB(B0, 1, 0); PG8_SCHED; PG8_LDA(At, 1, 0); PG8_STAGE(PG8_SA(0, 1), a2 + hstep, voffA);
            PG8_WAIT_L(8); PG8_BAR; PG8_WAIT_L(0); PG8_MMA(0, 0, At, B0); PG8_BAR; PG8_SCHED;
            PG8_LDB(B1, 1, 1); PG8_STAGE(PG8_SB(1, 0), b3, voffB);
            PG8_BAR; PG8_WAIT_L(0); PG8_MMA(0, 1, At, B1); PG8_BAR;
            PG8_LDA(At, 1, 1); PG8_STAGE(PG8_SA(1, 0), a3, voffA);
            PG8_BAR; PG8_WAIT_L(0); PG8_MMA(1, 0, At, B0); PG8_BAR; PG8_SCHED;
            PG8_STAGE(PG8_SB(1, 1), b3 + hstep, voffB);
            PG8_WAIT_V(6); PG8_BAR; PG8_MMA(1, 1, At, B1); PG8_BAR;
            }
        }
        if constexpr (ALIGN_EPI) { if (wr == 0) PG8_BAR; }
        if constexpr (!Epi::AFTER_DRAIN) { E(acc, cur, wr, wc, fr, fq); S.done(cur); }
        if (!has_next) break;
#pragma unroll
        for (int a = 0; a < 2; ++a)
#pragma unroll
            for (int b = 0; b < 2; ++b)
#pragma unroll
                for (int m = 0; m < 4; ++m)
#pragma unroll
                    for (int n = 0; n < 2; ++n) acc[a][b][m][n] = (f32x4){0.f, 0.f, 0.f, 0.f};
        cur = nxt; cA = nA; cB = nB; ++ui;
        if constexpr (ALIGN_EPI) { if (wr == 1) PG8_BAR; }
    }
    PG8_WAIT_V(0);
    if constexpr (!ALIGN_EPI) { if (wr == 0) PG8_BAR; }
    PG8_BAR;
    if constexpr (Epi::AFTER_DRAIN) { E.fused(acc, cur, wr, wc, fr, fq, lds, wid, lane); S.done(cur); }
#undef PG8_SA
#undef PG8_SB
#undef PG8_STAGE
#undef PG8_LDA
#undef PG8_LDB
#undef PG8_MMA
#undef PG8_WAIT_V
#undef PG8_WAIT_L
#undef PG8_BAR
#undef PG8_SCHED
}
template <class Epi, class Sched, bool ALIGN_EPI = false, bool SP2 = false>
__device__ __forceinline__ void gemm_phase_i8(PG8_LAS unsigned char* lds, const Gemm g, const Sched& S, const Epi& E) {
    int tid = threadIdx.x; asm volatile("" : "+v"(tid));
    const int wid = __builtin_amdgcn_readfirstlane(tid >> 6), lane = tid & 63, wr = wid >> 2, wc = wid & 3, fr = lane & 15, fq = lane >> 4;
    const int K = g.K, nt = K / BK;
    unsigned voffA[2], voffB[2];
#pragma unroll
    for (int i = 0; i < 2; ++i) { int R, C; stage_rc(tid * 16 + i * 8192, R, C); const int Rb = Epi::PERM ? ((R & ~31) + perm32(R & 31)) : R;
        voffA[i] = (unsigned)(R * K + C) * 2u; voffB[i] = (unsigned)(Rb * K + C) * 2u; }
    const size_t kstep = (size_t)(BK * 2);
    const size_t hstep = (size_t)HALF * K * 2;
    const size_t tstep = 2 * hstep;
    const unsigned ldsw = (unsigned)wid * 1024u;
    const int aoff = lds_byte(wr * 64 + fr, fq * 8), boff = lds_byte(wc * 32 + fr, fq * 8);
#define PG8_SA(b, h) (((b) * 2 + (h)) * HTB)
#define PG8_SB(b, h) ((4 + (b) * 2 + (h)) * HTB)
#define PG8_STAGE(bufoff, gbase, voff) do { _Pragma("unroll") for (int _i = 0; _i < 2; ++_i) \
        __builtin_amdgcn_global_load_lds((const unsigned*)((const char*)(gbase) + (voff)[_i]), (PG8_LAS unsigned*)(lds + (bufoff) + ldsw + _i * 8192), 16, 0, 0); } while (0)
#define PG8_LDA(dst, b, h) do { _Pragma("unroll") for (int m = 0; m < 4; ++m) _Pragma("unroll") for (int k = 0; k < 2; ++k) dst[m][k] = *(const PG8_LAS bf16x8*)(lds + PG8_SA(b, h) + aoff + m * 2048 + k * 1024); } while (0)
#define PG8_LDB(dst, b, h) do { _Pragma("unroll") for (int n = 0; n < 2; ++n) _Pragma("unroll") for (int k = 0; k < 2; ++k) dst[n][k] = *(const PG8_LAS bf16x8*)(lds + PG8_SB(b, h) + boff + n * 2048 + k * 1024); } while (0)
#define PG8_MMA(ai, bj, At, Bt) do { __builtin_amdgcn_s_setprio(1); _Pragma("unroll") for (int m = 0; m < 4; ++m) _Pragma("unroll") for (int n = 0; n < 2; ++n) _Pragma("unroll") for (int k = 0; k < 2; ++k) \
        acc[ai][bj][m][n] = __builtin_amdgcn_mfma_i32_16x16x64_i8(__builtin_bit_cast(i32x4, Bt[n][k]), __builtin_bit_cast(i32x4, At[m][k]), acc[ai][bj][m][n], 0, 0, 0); __builtin_amdgcn_s_setprio(0); } while (0)
#define PG8_WAIT_V(n) asm volatile("s_waitcnt vmcnt(" #n ")" ::: "memory")
#define PG8_WAIT_L(n) asm volatile("s_waitcnt lgkmcnt(" #n ")" ::: "memory")
#define PG8_BAR __builtin_amdgcn_s_barrier()
#define PG8_SCHED __builtin_amdgcn_sched_barrier(0)
    Unit cur, nxt; int ui = 0;
    if (!S.next(0, cur)) return;
    i32x4 acc[2][2][4][2];
#pragma unroll
    for (int a = 0; a < 2; ++a)
#pragma unroll
        for (int b = 0; b < 2; ++b)
#pragma unroll
            for (int m = 0; m < 4; ++m)
#pragma unroll
                for (int n = 0; n < 2; ++n) acc[a][b][m][n] = (i32x4){0, 0, 0, 0};
    bf16x8 At[4][2], B0[2][2], B1[2][2];
    const char* cA = (const char*)g.A + (size_t)cur.pm * tstep; const char* cB = (const char*)g.Bt + (size_t)cur.pn * tstep;
    S.a_ready(cur);
    if constexpr (SP2) {
        PG8_STAGE(PG8_SB(0, 0), cB, voffB); PG8_STAGE(PG8_SB(0, 1), cB + hstep, voffB); PG8_STAGE(PG8_SA(0, 0), cA, voffA); PG8_STAGE(PG8_SA(0, 1), cA + hstep, voffA);
        if (wr == 1) PG8_BAR;
        PG8_WAIT_V(2); PG8_BAR;
        PG8_STAGE(PG8_SB(1, 0), cB + kstep, voffB); PG8_STAGE(PG8_SA(1, 0), cA + kstep, voffA); PG8_STAGE(PG8_SB(1, 1), cB + hstep + kstep, voffB);
        PG8_WAIT_V(6); PG8_BAR;
    } else {
        PG8_STAGE(PG8_SB(0, 0), cB, voffB); PG8_STAGE(PG8_SA(0, 0), cA, voffA); PG8_STAGE(PG8_SB(0, 1), cB + hstep, voffB); PG8_STAGE(PG8_SA(0, 1), cA + hstep, voffA);
        if (wr == 1) PG8_BAR;
        PG8_WAIT_V(4); PG8_BAR;
        PG8_STAGE(PG8_SB(1, 0), cB + kstep, voffB); PG8_STAGE(PG8_SA(1, 0), cA + kstep, voffA); PG8_STAGE(PG8_SB(1, 1), cB + hstep + kstep, voffB);
        PG8_WAIT_V(6); PG8_BAR;
    }
    for (;;) {
        const bool has_next = S.next(ui + 1, nxt);
        const char* nA = has_next ? (const char*)g.A + (size_t)nxt.pm * tstep : cA; const char* nB = has_next ? (const char*)g.Bt + (size_t)nxt.pn * tstep : cB;
        for (int t = 0; t < nt; t += 2) {
            const bool last = (t == nt - 2);
            const char* a1 = cA + (size_t)(t + 1) * kstep;
            const char* a2 = last ? nA : cA + (size_t)(t + 2) * kstep; const char* b2 = last ? nB : cB + (size_t)(t + 2) * kstep;
            const char* a3 = a2 + kstep; const char* b3 = b2 + kstep;
            if (last && has_next) S.a_ready(nxt);
            if constexpr (SP2) {
            PG8_LDB(B0, 0, 0); PG8_LDB(B1, 0, 1); PG8_SCHED; PG8_LDA(At, 0, 0); PG8_STAGE(PG8_SA(1, 1), a1 + hstep, voffA);
            PG8_WAIT_V(8); PG8_WAIT_L(0); PG8_BAR; PG8_MMA(0, 0, At, B0); PG8_MMA(0, 1, At, B1); PG8_BAR; PG8_SCHED;
            PG8_LDA(At, 0, 1); PG8_STAGE(PG8_SB(0, 0), b2, voffB); PG8_STAGE(PG8_SB(0, 1), b2 + hstep, voffB); PG8_STAGE(PG8_SA(0, 0), a2, voffA);
            PG8_WAIT_V(8); PG8_WAIT_L(0); PG8_BAR; PG8_MMA(1, 0, At, B0); PG8_MMA(1, 1, At, B1); PG8_BAR; PG8_SCHED;
            PG8_LDB(B0, 1, 0); PG8_LDB(B1, 1, 1); PG8_SCHED; PG8_LDA(At, 1, 0); PG8_STAGE(PG8_SA(0, 1), a2 + hstep, voffA);
            PG8_WAIT_V(8); PG8_WAIT_L(0); PG8_BAR; PG8_MMA(0, 0, At, B0); PG8_MMA(0, 1, At, B1); PG8_BAR; PG8_SCHED;
            PG8_LDA(At, 1, 1); PG8_STAGE(PG8_SB(1, 0), b3, voffB); PG8_STAGE(PG8_SB(1, 1), b3 + hstep, voffB); PG8_STAGE(PG8_SA(1, 0), a3, voffA);
            PG8_WAIT_V(8); PG8_WAIT_L(0); PG8_BAR; PG8_MMA(1, 0, At, B0); PG8_MMA(1, 1, At, B1); PG8_BAR; PG8_SCHED;
            } else {
            PG8_LDB(B0, 0, 0); PG8_SCHED; PG8_LDA(At, 0, 0); PG8_STAGE(PG8_SA(1, 1), a1 + hstep, voffA);
            PG8_WAIT_L(8); PG8_BAR; PG8_WAIT_L(0); PG8_MMA(0, 0, At, B0); PG8_BAR; PG8_SCHED;
            PG8_LDB(B1, 0, 1); PG8_STAGE(PG8_SB(0, 0), b2, voffB);
            PG8_BAR; PG8_WAIT_L(0); PG8_MMA(0, 1, At, B1); PG8_BAR;
            PG8_LDA(At, 0, 1); PG8_STAGE(PG8_SA(0, 0), a2, voffA);
            PG8_BAR; PG8_WAIT_L(0); PG8_MMA(1, 0, At, B0); PG8_BAR; PG8_SCHED;
            PG8_STAGE(PG8_SB(0, 1), b2 + hstep, voffB);
            PG8_WAIT_V(6); PG8_BAR; PG8_MMA(1, 1, At, B1); PG8_BAR;
            PG8_LDB(B0, 1, 0); PG8_SCHED; PG8_LDA(At, 1, 0); PG8_STAGE(PG8_SA(0, 1), a2 + hstep, voffA);
            PG8_WAIT_L(8); PG8_BAR; PG8_WAIT_L(0); PG8_MMA(0, 0, At, B0); PG8_BAR; PG8_SCHED;
            PG8_LDB(B1, 1, 1); PG8_STAGE(PG8_SB(1, 0), b3, voffB);
            PG8_BAR; PG8_WAIT_L(0); PG8_MMA(0, 1, At, B1); PG8_BAR;
            PG8_LDA(At, 1, 1); PG8_STAGE(PG8_SA(1, 0), a3, voffA);
            PG8_BAR; PG8_WAIT_L(0); PG8_MMA(1, 0, At, B0); PG8_BAR; PG8_SCHED;
            PG8_STAGE(PG8_SB(1, 1), b3 + hstep, voffB);
            PG8_WAIT_V(6); PG8_BAR; PG8_MMA(1, 1, At, B1); PG8_BAR;
            }
        }
        if constexpr (ALIGN_EPI) { if (wr == 0) PG8_BAR; }
        if constexpr (!Epi::AFTER_DRAIN) { E(acc, cur, wr, wc, fr, fq); S.done(cur); }
        if (!has_next) break;
#pragma unroll
        for (int a = 0; a < 2; ++a)
#pragma unroll
            for (int b = 0; b < 2; ++b)
#pragma unroll
                for (int m = 0; m < 4; ++m)
#pragma unroll
                    for (int n = 0; n < 2; ++n) acc[a][b][m][n] = (i32x4){0, 0, 0, 0};
        cur = nxt; cA = nA; cB = nB; ++ui;
        if constexpr (ALIGN_EPI) { if (wr == 1) PG8_BAR; }
    }
    PG8_WAIT_V(0);
    if constexpr (!ALIGN_EPI) { if (wr == 0) PG8_BAR; }
    PG8_BAR;
    if constexpr (Epi::AFTER_DRAIN) { E.fused(acc, cur, wr, wc, fr, fq, lds, wid, lane); S.done(cur); }
#undef PG8_SA
#undef PG8_SB
#undef PG8_STAGE
#undef PG8_LDA
#undef PG8_LDB
#undef PG8_MMA
#undef PG8_WAIT_V
#undef PG8_WAIT_L
#undef PG8_BAR
#undef PG8_SCHED
}
}
namespace pg8 {
template <int ACT  > struct EpiBf {
    static constexpr bool PERM = true, AFTER_DRAIN = false;
    bf16_t* O; int ldc;
    __device__ __forceinline__ void operator()(const f32x4 (&acc)[2][2][4][2], const Unit& u, int wr, int wc, int fr, int fq) const {
        const int row0 = u.pm * BM + wr * 64 + fr, col0 = u.pn * BM + wc * 32 + 8 * fq;
#pragma unroll
        for (int ai = 0; ai < 2; ++ai)
#pragma unroll
            for (int m = 0; m < 4; ++m) { bf16_t* rowp = O + (size_t)(row0 + ai * HALF + m * 16) * ldc + col0;
#pragma unroll
                for (int bj = 0; bj < 2; ++bj) { f32x4 v0 = acc[ai][bj][m][0], v1 = acc[ai][bj][m][1];
                    if (ACT == 1) {
#pragma unroll
                        for (int j = 0; j < 4; ++j) { const float a = fmaxf(v0[j], 0.f), b = fmaxf(v1[j], 0.f); v0[j] = a * a; v1[j] = b * b; } }
                    u32x4 w; w.x = cvt_pk_bf16(v0[0], v0[1]); w.y = cvt_pk_bf16(v0[2], v0[3]); w.z = cvt_pk_bf16(v1[0], v1[1]); w.w = cvt_pk_bf16(v1[2], v1[3]);
                    *(u32x4*)(rowp + bj * HALF) = w; } }
    }
};
struct EpiUp {
    static constexpr bool PERM = true, AFTER_DRAIN = false;
    bf16_t* O; int ldc; unsigned* rmax;
    __device__ __forceinline__ void operator()(const f32x4 (&acc)[2][2][4][2], const Unit& u, int wr, int wc, int fr, int fq) const {
        const int row0 = u.pm * BM + wr * 64 + fr, col0 = u.pn * BM + wc * 32 + 8 * fq;
#pragma unroll
        for (int ai = 0; ai < 2; ++ai)
#pragma unroll
            for (int m = 0; m < 4; ++m) { const int row = row0 + ai * HALF + m * 16; bf16_t* rowp = O + (size_t)row * ldc + col0; float mx = 0.f;
#pragma unroll
                for (int bj = 0; bj < 2; ++bj) { f32x4 v0 = acc[ai][bj][m][0], v1 = acc[ai][bj][m][1];
#pragma unroll
                    for (int j = 0; j < 4; ++j) { const float a = fmaxf(v0[j], 0.f), b = fmaxf(v1[j], 0.f); v0[j] = a * a; v1[j] = b * b; mx = fmaxf(mx, fmaxf(v0[j], v1[j])); }
                    u32x4 w; w.x = cvt_pk_bf16(v0[0], v0[1]); w.y = cvt_pk_bf16(v0[2], v0[3]); w.z = cvt_pk_bf16(v1[0], v1[1]); w.w = cvt_pk_bf16(v1[2], v1[3]);
                    *(u32x4*)(rowp + bj * HALF) = w; }
                mx = fmaxf(mx, __shfl_xor(mx, 16)); mx = fmaxf(mx, __shfl_xor(mx, 32));
                if (fq == 0) __hip_atomic_fetch_max(rmax + row, __float_as_uint(mx), __ATOMIC_RELAXED, __HIP_MEMORY_SCOPE_AGENT); }
    }
};
struct EpiMixI8 {
    static constexpr bool PERM = true, AFTER_DRAIN = false;
    bf16_t* O; int ldc; const float* sA; const float* sB;
    __device__ __forceinline__ void operator()(const i32x4 (&acc)[2][2][4][2], const Unit& u, int wr, int wc, int fr, int fq) const {
        const int row0 = u.pm * BM + wr * 64 + fr, col0 = u.pn * BM + wc * 32 + 8 * fq;
        f32x4 sb[2][2];
#pragma unroll
        for (int bj = 0; bj < 2; ++bj)
#pragma unroll
            for (int n = 0; n < 2; ++n) sb[bj][n] = *(const f32x4*)(sB + col0 + bj * HALF + 4 * n);
        float sav[2][4];
#pragma unroll
        for (int ai = 0; ai < 2; ++ai)
#pragma unroll
            for (int m = 0; m < 4; ++m) sav[ai][m] = sA[row0 + ai * HALF + m * 16];
        asm volatile("" ::: "memory");
#pragma unroll
        for (int ai = 0; ai < 2; ++ai)
#pragma unroll
            for (int m = 0; m < 4; ++m) { const int row = row0 + ai * HALF + m * 16; bf16_t* rowp = O + (size_t)row * ldc + col0; const float sa = sav[ai][m];
#pragma unroll
                for (int bj = 0; bj < 2; ++bj) { f32x4 v0, v1;
#pragma unroll
                    for (int j = 0; j < 4; ++j) { v0[j] = (float)acc[ai][bj][m][0][j] * sb[bj][0][j] * sa; v1[j] = (float)acc[ai][bj][m][1][j] * sb[bj][1][j] * sa; }
                    u32x4 w; w.x = cvt_pk_bf16(v0[0], v0[1]); w.y = cvt_pk_bf16(v0[2], v0[3]); w.z = cvt_pk_bf16(v1[0], v1[1]); w.w = cvt_pk_bf16(v1[2], v1[3]);
                    *(u32x4*)(rowp + bj * HALF) = w; } }
    }
};
struct EpiUpI8 {
    static constexpr bool PERM = true, AFTER_DRAIN = false;
    bf16_t* O; int ldc; unsigned* rmax; const float* sA; const float* sB;
    __device__ __forceinline__ void operator()(const i32x4 (&acc)[2][2][4][2], const Unit& u, int wr, int wc, int fr, int fq) const {
        const int row0 = u.pm * BM + wr * 64 + fr, col0 = u.pn * BM + wc * 32 + 8 * fq;
        f32x4 sb[2][2];
#pragma unroll
        for (int bj = 0; bj < 2; ++bj)
#pragma unroll
            for (int n = 0; n < 2; ++n) sb[bj][n] = *(const f32x4*)(sB + col0 + bj * HALF + 4 * n);
        float sav[2][4];
#pragma unroll
        for (int ai = 0; ai < 2; ++ai)
#pragma unroll
            for (int m = 0; m < 4; ++m) sav[ai][m] = sA[row0 + ai * HALF + m * 16];
        asm volatile("" ::: "memory");
#pragma unroll
        for (int ai = 0; ai < 2; ++ai)
#pragma unroll
            for (int m = 0; m < 4; ++m) { const int row = row0 + ai * HALF + m * 16; bf16_t* rowp = O + (size_t)row * ldc + col0; const float sa = sav[ai][m]; float mx = 0.f;
#pragma unroll
                for (int bj = 0; bj < 2; ++bj) { f32x4 v0, v1;
#pragma unroll
                    for (int j = 0; j < 4; ++j) { const float a = fmaxf((float)acc[ai][bj][m][0][j] * sb[bj][0][j] * sa, 0.f), b = fmaxf((float)acc[ai][bj][m][1][j] * sb[bj][1][j] * sa, 0.f);
                        v0[j] = a * a; v1[j] = b * b; mx = fmaxf(mx, fmaxf(v0[j], v1[j])); }
                    u32x4 w; w.x = cvt_pk_bf16(v0[0], v0[1]); w.y = cvt_pk_bf16(v0[2], v0[3]); w.z = cvt_pk_bf16(v1[0], v1[1]); w.w = cvt_pk_bf16(v1[2], v1[3]);
                    *(u32x4*)(rowp + bj * HALF) = w; }
                mx = fmaxf(mx, __shfl_xor(mx, 16)); mx = fmaxf(mx, __shfl_xor(mx, 32));
                if (fq == 0) __hip_atomic_fetch_max(rmax + row, __float_as_uint(mx), __ATOMIC_RELAXED, __HIP_MEMORY_SCOPE_AGENT); }
    }
};
struct EpiUpI8L {
    static constexpr bool PERM = true, AFTER_DRAIN = false;
    unsigned char* Oq; int ldc; float* LM; const float* sA; const float* sB;
    __device__ __forceinline__ void operator()(const i32x4 (&acc)[2][2][4][2], const Unit& u, int wr, int wc, int fr, int fq) const {
        const int row0 = u.pm * BM + wr * 64 + fr, col0 = u.pn * BM + wc * 32 + 8 * fq, nlb = ldc >> 6;
        f32x4 sb[2][2];
#pragma unroll
        for (int bj = 0; bj < 2; ++bj)
#pragma unroll
            for (int n = 0; n < 2; ++n) sb[bj][n] = *(const f32x4*)(sB + col0 + bj * HALF + 4 * n);
        float sav[2][4];
#pragma unroll
        for (int ai = 0; ai < 2; ++ai)
#pragma unroll
            for (int m = 0; m < 4; ++m) sav[ai][m] = sA[row0 + ai * HALF + m * 16];
        asm volatile("" ::: "memory");
#pragma unroll
        for (int ai = 0; ai < 2; ++ai)
#pragma unroll
            for (int m = 0; m < 4; ++m) { const int row = row0 + ai * HALF + m * 16; const float sa = sav[ai][m]; float uu[2][8]; float mx = 0.f;
#pragma unroll
                for (int bj = 0; bj < 2; ++bj)
#pragma unroll
                    for (int j = 0; j < 4; ++j) { const int ia = acc[ai][bj][m][0][j], ib = acc[ai][bj][m][1][j];
                        const float a = (float)(ia > 0 ? ia : 0) * sb[bj][0][j], b = (float)(ib > 0 ? ib : 0) * sb[bj][1][j];
                        uu[bj][j] = a * a; uu[bj][4 + j] = b * b; mx = fmaxf(mx, fmaxf(uu[bj][j], uu[bj][4 + j])); }
                mx = fmaxf(mx, __shfl_xor(mx, 16)); mx = fmaxf(mx, __shfl_xor(mx, 32));
                const float inv = mx > 0.f ? 255.f / mx : 0.f;
                unsigned char* rowp = Oq + (size_t)row * ldc + col0;
#pragma unroll
                for (int bj = 0; bj < 2; ++bj) { unsigned w[2];
#pragma unroll
                    for (int h2 = 0; h2 < 2; ++h2) { unsigned t[4];
#pragma unroll
                        for (int e = 0; e < 4; ++e) t[e] = __float_as_uint(fmaf(uu[bj][4 * h2 + e], inv, 12582784.f));
                        w[h2] = __builtin_amdgcn_perm(__builtin_amdgcn_perm(t[3], t[2], 0x0c0c0400u), __builtin_amdgcn_perm(t[1], t[0], 0x0c0c0400u), 0x05040100u); }
                    typedef unsigned u32x2 __attribute__((ext_vector_type(2)));
                    *(u32x2*)(rowp + bj * HALF) = (u32x2){w[0], w[1]}; }
                if (fq == 0) LM[(size_t)row * nlb + u.pn * 4 + wc] = mx * sa * sa; }
    }
};
struct EpiDownI8 {
    static constexpr bool PERM = true, AFTER_DRAIN = false;
    bf16_t* O; int ldc; const float* sA; const float* sB; const int* CS;
    __device__ __forceinline__ void operator()(const i32x4 (&acc)[2][2][4][2], const Unit& u, int wr, int wc, int fr, int fq) const {
        const int row0 = u.pm * BM + wr * 64 + fr, col0 = u.pn * BM + wc * 32 + 8 * fq;
        f32x4 sb[2][2]; i32x4 cs[2][2];
#pragma unroll
        for (int bj = 0; bj < 2; ++bj)
#pragma unroll
            for (int n = 0; n < 2; ++n) { sb[bj][n] = *(const f32x4*)(sB + col0 + bj * HALF + 4 * n); cs[bj][n] = *(const i32x4*)(CS + col0 + bj * HALF + 4 * n) * 128; }
        float sav[2][4];
#pragma unroll
        for (int ai = 0; ai < 2; ++ai)
#pragma unroll
            for (int m = 0; m < 4; ++m) sav[ai][m] = sA[row0 + ai * HALF + m * 16];
        asm volatile("" ::: "memory");
#pragma unroll
        for (int ai = 0; ai < 2; ++ai)
#pragma unroll
            for (int m = 0; m < 4; ++m) { const int row = row0 + ai * HALF + m * 16; const float sa = sav[ai][m]; bf16_t* rowp = O + (size_t)row * ldc + col0;
#pragma unroll
                for (int bj = 0; bj < 2; ++bj) { const i32x4 a0 = acc[ai][bj][m][0] + cs[bj][0], a1 = acc[ai][bj][m][1] + cs[bj][1];
                    f32x4 v0, v1;
#pragma unroll
                    for (int j = 0; j < 4; ++j) { v0[j] = (float)a0[j] * sb[bj][0][j] * sa; v1[j] = (float)a1[j] * sb[bj][1][j] * sa; }
                    u32x4 w; w.x = cvt_pk_bf16(v0[0], v0[1]); w.y = cvt_pk_bf16(v0[2], v0[3]); w.z = cvt_pk_bf16(v1[0], v1[1]); w.w = cvt_pk_bf16(v1[2], v1[3]);
                    *(u32x4*)(rowp + bj * HALF) = w; } }
    }
};
struct EpiIn {
    static constexpr bool PERM = true, AFTER_DRAIN = false;
    bf16_t *KP, *KS, *VP, *VS, *XR; float *DT, *outK, *outV; int pn0, row0;
    __device__ __forceinline__ void operator()(const f32x4 (&acc)[2][2][4][2], const Unit& u, int wr, int wc, int fr, int fq) const {
        const int pn = u.pn + pn0, rl = wr * 64 + fr, cl = wc * 32 + 8 * fq;
        const int rowt = row0 + u.pm * BM;
        bf16_t* bdst = nullptr; float* fdst = nullptr; int ldb = 2048; size_t brow = (size_t)rowt; int colb = 0;
        if (pn < 16) {
            const bool isv = pn >= 8; colb = (pn - (isv ? 8 : 0)) * 256;
            if (rowt < 8192) { bdst = isv ? VP : KP; fdst = isv ? outV : outK; }
            else { const int sr = rowt - 8192, b = sr >> 12, t = sr & 4095; bdst = isv ? VS : KS; brow = (size_t)b * 4608 + 512 + t; }
        }
        else if (pn < 28) { bdst = XR; ldb = 3072; colb = (pn - 16) * 256; }
        if (pn < 28) {
#pragma unroll
            for (int ai = 0; ai < 2; ++ai)
#pragma unroll
                for (int m = 0; m < 4; ++m) { const int r = rl + ai * HALF + m * 16;
#pragma unroll
                    for (int bj = 0; bj < 2; ++bj) { const f32x4 v0 = acc[ai][bj][m][0], v1 = acc[ai][bj][m][1]; const int c = colb + cl + bj * HALF;
                        u32x4 w; w.x = cvt_pk_bf16(v0[0], v0[1]); w.y = cvt_pk_bf16(v0[2], v0[3]); w.z = cvt_pk_bf16(v1[0], v1[1]); w.w = cvt_pk_bf16(v1[2], v1[3]);
                        *(u32x4*)(bdst + (brow + r) * ldb + c) = w;
                        if (fdst) { float* fp = fdst + (size_t)(rowt + r) * 2048 + c; *(f32x4*)fp = v0; *(f32x4*)(fp + 4) = v1; } } }
        } else {
            if (cl < 64) {
#pragma unroll
                for (int ai = 0; ai < 2; ++ai)
#pragma unroll
                    for (int m = 0; m < 4; ++m) { const int r = rowt + rl + ai * HALF + m * 16; float* fp = DT + (size_t)r * 64 + cl;
                        *(f32x4*)fp = acc[ai][0][m][0]; *(f32x4*)(fp + 4) = acc[ai][0][m][1]; }
            }
        }
    }
};
struct EpiQZ {
    static constexpr bool PERM = true, AFTER_DRAIN = false;
    bf16_t *Q, *Z; const float* sA; const float* sB;
    __device__ __forceinline__ void operator()(const i32x4 (&acc)[2][2][4][2], const Unit& u, int wr, int wc, int fr, int fq) const {
        const int row0 = u.pm * BM + wr * 64 + fr, cl = wc * 32 + 8 * fq, colv = u.pn * BM + cl;
        bf16_t* dst = u.pn < 8 ? Q : Z; const int cold = (u.pn & 7) * BM + cl;
        f32x4 sb[2][2];
#pragma unroll
        for (int bj = 0; bj < 2; ++bj)
#pragma unroll
            for (int n = 0; n < 2; ++n) sb[bj][n] = *(const f32x4*)(sB + colv + bj * HALF + 4 * n);
        float sav[2][4];
#pragma unroll
        for (int ai = 0; ai < 2; ++ai)
#pragma unroll
            for (int m = 0; m < 4; ++m) sav[ai][m] = sA[row0 + ai * HALF + m * 16];
        asm volatile("" ::: "memory");
#pragma unroll
        for (int ai = 0; ai < 2; ++ai)
#pragma unroll
            for (int m = 0; m < 4; ++m) { const int row = row0 + ai * HALF + m * 16; bf16_t* rowp = dst + (size_t)row * 2048 + cold; const float sa = sav[ai][m];
#pragma unroll
                for (int bj = 0; bj < 2; ++bj) { f32x4 v0, v1;
#pragma unroll
                    for (int j = 0; j < 4; ++j) { v0[j] = (float)acc[ai][bj][m][0][j] * sb[bj][0][j] * sa; v1[j] = (float)acc[ai][bj][m][1][j] * sb[bj][1][j] * sa; }
                    u32x4 w; w.x = cvt_pk_bf16(v0[0], v0[1]); w.y = cvt_pk_bf16(v0[2], v0[3]); w.z = cvt_pk_bf16(v1[0], v1[1]); w.w = cvt_pk_bf16(v1[2], v1[3]);
                    *(u32x4*)(rowp + bj * HALF) = w; } }
    }
};
struct EpiKVs {
    static constexpr bool PERM = true, AFTER_DRAIN = false;
    bf16_t *KS, *VS; const float* sA; const float* sB;
    __device__ __forceinline__ void operator()(const i32x4 (&acc)[2][2][4][2], const Unit& u, int wr, int wc, int fr, int fq) const {
        const int rl = wr * 64 + fr, cl = wc * 32 + 8 * fq, colv = u.pn * BM + cl, sr = u.pm * BM, b = sr >> 12, t = sr & 4095;
        bf16_t* dst = (u.pn < 8 ? KS : VS) + ((size_t)b * 4608 + 512 + t) * 2048 + (u.pn & 7) * BM + cl;
        f32x4 sb[2][2];
#pragma unroll
        for (int bj = 0; bj < 2; ++bj)
#pragma unroll
            for (int n = 0; n < 2; ++n) sb[bj][n] = *(const f32x4*)(sB + colv + bj * HALF + 4 * n);
        float sav[2][4];
#pragma unroll
        for (int ai = 0; ai < 2; ++ai)
#pragma unroll
            for (int m = 0; m < 4; ++m) sav[ai][m] = sA[sr + rl + ai * HALF + m * 16];
        asm volatile("" ::: "memory");
#pragma unroll
        for (int ai = 0; ai < 2; ++ai)
#pragma unroll
            for (int m = 0; m < 4; ++m) { const int r = rl + ai * HALF + m * 16; bf16_t* rowp = dst + (size_t)r * 2048; const float sa = sav[ai][m];
#pragma unroll
                for (int bj = 0; bj < 2; ++bj) { f32x4 v0, v1;
#pragma unroll
                    for (int j = 0; j < 4; ++j) { v0[j] = (float)acc[ai][bj][m][0][j] * sb[bj][0][j] * sa; v1[j] = (float)acc[ai][bj][m][1][j] * sb[bj][1][j] * sa; }
                    u32x4 w; w.x = cvt_pk_bf16(v0[0], v0[1]); w.y = cvt_pk_bf16(v0[2], v0[3]); w.z = cvt_pk_bf16(v1[0], v1[1]); w.w = cvt_pk_bf16(v1[2], v1[3]);
                    *(u32x4*)(rowp + bj * HALF) = w; } }
    }
};
struct EpiKVa {
    static constexpr bool PERM = true, AFTER_DRAIN = false;
    bf16_t *KP, *KS, *VP, *VS; float *outK, *outV; const float* sA; const float* sB;
    __device__ __forceinline__ void operator()(const i32x4 (&acc)[2][2][4][2], const Unit& u, int wr, int wc, int fr, int fq) const {
        const int rl = wr * 64 + fr, cl = wc * 32 + 8 * fq, colv = u.pn * BM + cl, rowt = u.pm * BM, colb = (u.pn & 7) * BM + cl; const bool isv = u.pn >= 8;
        bf16_t* dst; float* fdst = nullptr;
        if (rowt < 8192) { dst = (isv ? VP : KP) + (size_t)rowt * 2048 + colb; fdst = (isv ? outV : outK) + (size_t)rowt * 2048 + colb; }
        else { const int sr = rowt - 8192, b = sr >> 12, t = sr & 4095; dst = (isv ? VS : KS) + ((size_t)b * 4608 + 512 + t) * 2048 + colb; }
        f32x4 sb[2][2];
#pragma unroll
        for (int bj = 0; bj < 2; ++bj)
#pragma unroll
            for (int n = 0; n < 2; ++n) sb[bj][n] = *(const f32x4*)(sB + colv + bj * HALF + 4 * n);
        float sav[2][4];
#pragma unroll
        for (int ai = 0; ai < 2; ++ai)
#pragma unroll
            for (int m = 0; m < 4; ++m) sav[ai][m] = sA[rowt + rl + ai * HALF + m * 16];
        asm volatile("" ::: "memory");
#pragma unroll
        for (int ai = 0; ai < 2; ++ai)
#pragma unroll
            for (int m = 0; m < 4; ++m) { const int r = rl + ai * HALF + m * 16; bf16_t* rowp = dst + (size_t)r * 2048; const float sa = sav[ai][m];
#pragma unroll
                for (int bj = 0; bj < 2; ++bj) { f32x4 v0, v1;
#pragma unroll
                    for (int j = 0; j < 4; ++j) { v0[j] = (float)acc[ai][bj][m][0][j] * sb[bj][0][j] * sa; v1[j] = (float)acc[ai][bj][m][1][j] * sb[bj][1][j] * sa; }
                    u32x4 w; w.x = cvt_pk_bf16(v0[0], v0[1]); w.y = cvt_pk_bf16(v0[2], v0[3]); w.z = cvt_pk_bf16(v1[0], v1[1]); w.w = cvt_pk_bf16(v1[2], v1[3]);
                    *(u32x4*)(rowp + bj * HALF) = w;
                    if (fdst) { float* fp = fdst + (size_t)r * 2048 + bj * HALF; *(f32x4*)fp = v0; *(f32x4*)(fp + 4) = v1; } } }
    }
};
struct EpiXs {
    static constexpr bool PERM = true, AFTER_DRAIN = false;
    bf16_t* XR; const float* sA; const float* sB;
    __device__ __forceinline__ void operator()(const i32x4 (&acc)[2][2][4][2], const Unit& u, int wr, int wc, int fr, int fq) const {
        const int row0 = u.pm * BM + wr * 64 + fr, col0 = u.pn * BM + wc * 32 + 8 * fq;
        f32x4 sb[2][2];
#pragma unroll
        for (int bj = 0; bj < 2; ++bj)
#pragma unroll
            for (int n = 0; n < 2; ++n) sb[bj][n] = *(const f32x4*)(sB + col0 + bj * HALF + 4 * n);
        float sav[2][4];
#pragma unroll
        for (int ai = 0; ai < 2; ++ai)
#pragma unroll
            for (int m = 0; m < 4; ++m) sav[ai][m] = sA[row0 + ai * HALF + m * 16];
        asm volatile("" ::: "memory");
#pragma unroll
        for (int ai = 0; ai < 2; ++ai)
#pragma unroll
            for (int m = 0; m < 4; ++m) { const int row = row0 + ai * HALF + m * 16; bf16_t* rowp = XR + (size_t)row * 3072 + col0; const float sa = sav[ai][m];
#pragma unroll
                for (int bj = 0; bj < 2; ++bj) { f32x4 v0, v1;
#pragma unroll
                    for (int j = 0; j < 4; ++j) { v0[j] = (float)acc[ai][bj][m][0][j] * sb[bj][0][j] * sa; v1[j] = (float)acc[ai][bj][m][1][j] * sb[bj][1][j] * sa; }
                    u32x4 w; w.x = cvt_pk_bf16(v0[0], v0[1]); w.y = cvt_pk_bf16(v0[2], v0[3]); w.z = cvt_pk_bf16(v1[0], v1[1]); w.w = cvt_pk_bf16(v1[2], v1[3]);
                    *(u32x4*)(rowp + bj * HALF) = w; } }
    }
};
}

namespace att {
typedef unsigned short bf16;
constexpr int   D = 128, NW = 8, QBLK = 32, KVBLK = 64;
constexpr float SCALE = 0.088388347648318440f;
constexpr float THR = 8.f;
constexpr int SDEPTH = 2;
constexpr int LDQ = 2048, LDK = 2048;
constexpr size_t SHM_V = KVBLK * D * 2, SHM_K = KVBLK * D * 2, SHM_ATTN = 2 * SHM_V + 2 * SHM_K + NW * 64 * 4;
using bf16x8 = __attribute__((ext_vector_type(8))) short;
using s16x4  = __attribute__((ext_vector_type(4))) short;
using f32x16 = __attribute__((ext_vector_type(16))) float;
using u32x4  = __attribute__((ext_vector_type(4))) unsigned;
using f32x4v = __attribute__((ext_vector_type(4))) float;
#define KSWZ(row, colB) ((row) * 256 + ((colB) ^ (((row) & 7) << 4)))
#define SBAR() __builtin_amdgcn_sched_barrier(0)
__device__ __forceinline__ int crow(int r, int hi) { return (r & 3) + 8 * (r >> 2) + 4 * hi; }
__device__ __forceinline__ unsigned cvtpk(float lo, float hi) {
  unsigned r; asm volatile("v_cvt_pk_bf16_f32 %0, %1, %2" : "=v"(r) : "v"(lo), "v"(hi)); return r;
}
__device__ __forceinline__ bf16x8 ld8(const bf16* p) { return *reinterpret_cast<const bf16x8*>(p); }

__device__ __forceinline__ void partialSM(f32x16& p0, f32x16& p1, float& m_reg, float& mn, float& alpha) {
  constexpr float C = SCALE * 1.4426950408889634f;
  float pmax = p0[0]; for (int r = 1; r < 16; ++r) pmax = fmaxf(pmax, p0[r]); for (int r = 0; r < 16; ++r) pmax = fmaxf(pmax, p1[r]);
  { auto rr = __builtin_amdgcn_permlane32_swap(__float_as_uint(pmax), __float_as_uint(pmax), false, false);
    pmax = fmaxf(__uint_as_float(rr[0]), __uint_as_float(rr[1])); }
  if (__builtin_expect(__all(pmax - m_reg <= THR / SCALE), 1)) { mn = m_reg; alpha = 1.f; }
  else { mn = fmaxf(m_reg, pmax); alpha = __builtin_amdgcn_exp2f((m_reg - mn) * C); m_reg = mn; }
  float mnC = -mn * C;
  for (int r = 0; r < 16; ++r) p0[r] = fmaf(p0[r], C, mnC); for (int r = 0; r < 16; ++r) p1[r] = fmaf(p1[r], C, mnC);
  for (int r = 0; r < 16; ++r) p0[r] = __builtin_amdgcn_exp2f(p0[r]);
}
__device__ __forceinline__ void finishSM(f32x16& p0, f32x16& p1, float alpha, float& l_reg, bf16x8& pa0, bf16x8& pa1, bf16x8& pa2, bf16x8& pa3) {
  for (int r = 0; r < 16; ++r) p1[r] = __builtin_amdgcn_exp2f(p1[r]);
  float ps = 0; for (int r = 0; r < 16; ++r) ps += p0[r]; for (int r = 0; r < 16; ++r) ps += p1[r];
  { auto rr = __builtin_amdgcn_permlane32_swap(__float_as_uint(ps), __float_as_uint(ps), false, false);
    ps = __uint_as_float(rr[0]) + __uint_as_float(rr[1]); }
  l_reg = l_reg * alpha + ps;
#define PK4(P, BASE, OUT) do { unsigned a0 = cvtpk(P[BASE + 0], P[BASE + 1]), a1 = cvtpk(P[BASE + 2], P[BASE + 3]);   \
    unsigned b0 = cvtpk(P[BASE + 4], P[BASE + 5]), b1 = cvtpk(P[BASE + 6], P[BASE + 7]);                              \
    auto r0 = __builtin_amdgcn_permlane32_swap(a0, b0, false, false); auto r1 = __builtin_amdgcn_permlane32_swap(a1, b1, false, false); \
    u32x4 w = {r0[0], r1[0], r0[1], r1[1]}; OUT = *reinterpret_cast<bf16x8*>(&w); } while (0)
  PK4(p0, 0, pa0); PK4(p0, 8, pa1); PK4(p1, 0, pa2); PK4(p1, 8, pa3);
#undef PK4
}
__device__ __forceinline__ void qkt(f32x16& p0, f32x16& p1, const bf16* Ks, const bf16x8* qr, int r32, int hi) {
  p0 = f32x16{}; p1 = f32x16{};
  for (int d0 = 0; d0 < 8; ++d0) { int cb = (d0 * 16 + hi * 8) * 2;
    bf16x8 b0 = *reinterpret_cast<const bf16x8*>((const char*)Ks + KSWZ(r32, cb));
    bf16x8 b1 = *reinterpret_cast<const bf16x8*>((const char*)Ks + KSWZ(32 + r32, cb));
    p0 = __builtin_amdgcn_mfma_f32_32x32x16_bf16(b0, qr[d0], p0, 0, 0, 0);
    p1 = __builtin_amdgcn_mfma_f32_32x32x16_bf16(b1, qr[d0], p1, 0, 0, 0); }
}
__device__ __forceinline__ int v_st(int k, int c) { const int kk = (k & ~0xC) | ((k & 4) << 1) | ((k & 8) >> 1); return ((kk >> 3) * 4 + (c >> 5)) * 512 + ((kk & 7) * 32 + (c & 31)) * 2; }
__device__ __forceinline__ int v_rd_base(int lane) { return ((lane & 3) << 3) | (((lane >> 2) & 3) << 6) | (((lane >> 4) & 1) << 5) | (((lane >> 5) & 1) << 8); }
constexpr int v_rd_off(int d0, int ks, int half) { return d0 * 512 + ks * 4096 + half * 2048; }
template <int OFF> __device__ __forceinline__ s16x4 tr_read(int vb) {
  s16x4 r; asm volatile("ds_read_b64_tr_b16 %0, %1 offset:%2" : "=&v"(r) : "v"(vb), "i"(OFF) : "memory"); return r;
}
template <int D0> __device__ __forceinline__ void pv_one(f32x16& od, int vb, bf16x8 pa0, bf16x8 pa1, bf16x8 pa2, bf16x8 pa3) {
  const s16x4 l0 = tr_read<v_rd_off(D0, 0, 0)>(vb), h0 = tr_read<v_rd_off(D0, 0, 1)>(vb), l1 = tr_read<v_rd_off(D0, 1, 0)>(vb), h1 = tr_read<v_rd_off(D0, 1, 1)>(vb);
  const s16x4 l2 = tr_read<v_rd_off(D0, 2, 0)>(vb), h2 = tr_read<v_rd_off(D0, 2, 1)>(vb), l3 = tr_read<v_rd_off(D0, 3, 0)>(vb), h3 = tr_read<v_rd_off(D0, 3, 1)>(vb);
  asm volatile("s_waitcnt lgkmcnt(0)" ::: "memory"); SBAR();
#define PK(L, H) (bf16x8){L[0], L[1], L[2], L[3], H[0], H[1], H[2], H[3]}
  od = __builtin_amdgcn_mfma_f32_32x32x16_bf16(pa0, PK(l0, h0), od, 0, 0, 0);
  od = __builtin_amdgcn_mfma_f32_32x32x16_bf16(pa1, PK(l1, h1), od, 0, 0, 0);
  od = __builtin_amdgcn_mfma_f32_32x32x16_bf16(pa2, PK(l2, h2), od, 0, 0, 0);
  od = __builtin_amdgcn_mfma_f32_32x32x16_bf16(pa3, PK(l3, h3), od, 0, 0, 0);
#undef PK
}
__device__ __forceinline__ void pv_d0(f32x16* o, int vb, bf16x8 pa0, bf16x8 pa1, bf16x8 pa2, bf16x8 pa3) {
  pv_one<0>(o[0], vb, pa0, pa1, pa2, pa3); pv_one<1>(o[1], vb, pa0, pa1, pa2, pa3); pv_one<2>(o[2], vb, pa0, pa1, pa2, pa3); pv_one<3>(o[3], vb, pa0, pa1, pa2, pa3);
}

__device__ __forceinline__ void attn_dense_body(const int PASS, const bf16* __restrict__ Qb, const bf16* __restrict__ Kh, const bf16* __restrict__ Vh,
                                                float* __restrict__ scr, bf16* __restrict__ Ob, float lam, int seq, char* lds) {
  int tid = threadIdx.x; asm volatile("" : "+v"(tid));
  const int wid = tid >> 6, lane = tid & 63, r32 = lane & 31, hi = lane >> 5;
  bf16* V_lds = (bf16*)lds; bf16* K_lds = (bf16*)(lds + 2 * SHM_V);
  float* ws = (float*)(lds + 2 * SHM_V + 2 * SHM_K) + wid * 64; float* li_l = ws; float* al_l = ws + 32;
  float m_reg = -1e30f, l_reg = 0; f32x16 o[4] = {}; bf16x8 qr[8];
  const bf16* Qw = Qb + (long)(wid * QBLK + r32) * LDQ + hi * 8;
#pragma unroll
  for (int d0 = 0; d0 < 8; ++d0) qr[d0] = ld8(Qw + d0 * 16);
  const int sr = tid >> 4, sc = (tid & 15) * 8, vst0 = v_st(sr, sc), vst1 = v_st(32 + sr, sc);
  const int vb0 = (int)(uintptr_t)V_lds + v_rd_base(lane);
  struct { bf16x8 vs0, vs1, ks0, ks1; } sr_[SDEPTH];
#define SLOAD(i, k0) do { sr_[i].vs0 = ld8(&Vh[(long)((k0) + sr) * LDK + sc]); sr_[i].vs1 = ld8(&Vh[(long)((k0) + 32 + sr) * LDK + sc]); \
    sr_[i].ks0 = ld8(&Kh[(long)((k0) + sr) * LDK + sc]); sr_[i].ks1 = ld8(&Kh[(long)((k0) + 32 + sr) * LDK + sc]); } while (0)
#define SWRITE(b, i) do { *(bf16x8*)((char*)V_lds + (b) * SHM_V + vst0) = sr_[i].vs0;          \
    *(bf16x8*)((char*)V_lds + (b) * SHM_V + vst1) = sr_[i].vs1; int kc = sc * 2;               \
    *(bf16x8*)((char*)K_lds + (b) * SHM_K + KSWZ(sr, kc)) = sr_[i].ks0;                       \
    *(bf16x8*)((char*)K_lds + (b) * SHM_K + KSWZ(32 + sr, kc)) = sr_[i].ks1; } while (0)
#define SWAIT() do { if constexpr (SDEPTH == 2) asm volatile("s_waitcnt vmcnt(4)" ::: "memory"); else asm volatile("s_waitcnt vmcnt(0)" ::: "memory"); } while (0)
#define RESC(a) do { if (__any((a) < 1.f)) { if (hi == 0) al_l[r32] = (a); asm volatile("s_waitcnt lgkmcnt(0)" ::: "memory"); \
    for (int d = 0; d < 4; ++d) for (int r = 0; r < 16; ++r) o[d][r] *= al_l[crow(r, hi)]; } } while (0)
  f32x16 pA0, pA1, pB0, pB1; float mnA, mnB, alA, alB; bf16x8 pa0, pa1, pa2, pa3; const int NT = seq / KVBLK;
  constexpr int SE = 0, SO = SDEPTH - 1;
  SLOAD(SE, 0); asm volatile("s_waitcnt vmcnt(0)" ::: "memory"); SWRITE(0, SE); __syncthreads();
  qkt(pA0, pA1, K_lds, qr, r32, hi); partialSM(pA0, pA1, m_reg, mnA, alA);
  SLOAD(SO, KVBLK); if constexpr (SDEPTH == 2) { if (2 < NT) SLOAD(SE, 2 * KVBLK); }
  SWAIT(); SWRITE(1, SO); __syncthreads();
  for (int j = 1; j + 1 < NT; j += 2) {
    SBAR(); qkt(pB0, pB1, (bf16*)((char*)K_lds + SHM_K), qr, r32, hi);
    finishSM(pA0, pA1, alA, l_reg, pa0, pa1, pa2, pa3); SBAR();
    SLOAD(SO, (j + SDEPTH) * KVBLK); SBAR();
    pv_d0(o, vb0, pa0, pa1, pa2, pa3); partialSM(pB0, pB1, m_reg, mnB, alB);
    __syncthreads(); SWAIT(); SWRITE(0, SE);
    RESC(alB); __syncthreads();
    SBAR(); qkt(pA0, pA1, K_lds, qr, r32, hi);
    finishSM(pB0, pB1, alB, l_reg, pa0, pa1, pa2, pa3); SBAR();
    if (SDEPTH == 1 || j + 3 < NT) SLOAD(SE, (j + 1 + SDEPTH) * KVBLK); SBAR();
    pv_d0(o, vb0 + (int)SHM_V, pa0, pa1, pa2, pa3); partialSM(pA0, pA1, m_reg, mnA, alA);
    __syncthreads(); SWAIT(); SWRITE(1, SO);
    RESC(alA); __syncthreads();
  }
  SBAR(); qkt(pB0, pB1, (bf16*)((char*)K_lds + SHM_K), qr, r32, hi);
  finishSM(pA0, pA1, alA, l_reg, pa0, pa1, pa2, pa3); SBAR();
  pv_d0(o, vb0, pa0, pa1, pa2, pa3); partialSM(pB0, pB1, m_reg, mnB, alB);
  __syncthreads(); RESC(alB);
  finishSM(pB0, pB1, alB, l_reg, pa0, pa1, pa2, pa3); SBAR();
  pv_d0(o, vb0 + (int)SHM_V, pa0, pa1, pa2, pa3);
  if (hi == 0) li_l[r32] = l_reg; asm volatile("s_waitcnt lgkmcnt(0)" ::: "memory");
  float rli[16];
#pragma unroll
  for (int r = 0; r < 16; ++r) rli[r] = __builtin_amdgcn_rcpf(li_l[crow(r, hi)]);
  float* sp = scr + tid;
  if (PASS == 0) {
#pragma unroll
    for (int r = 0; r < 16; ++r)
#pragma unroll
      for (int d0 = 0; d0 < 4; ++d0) sp[(d0 * 16 + r) * 512] = o[d0][r] * rli[r];
  } else {
    bf16* Ow = Ob + (long)(wid * QBLK) * LDQ;
#pragma unroll
    for (int r = 0; r < 16; ++r) { const int orow = crow(r, hi);
#pragma unroll
      for (int d0 = 0; d0 < 4; ++d0) { const float v = sp[(d0 * 16 + r) * 512] - lam * (o[d0][r] * rli[r]);
        Ow[(long)orow * LDQ + d0 * 32 + r32] = (bf16)(cvtpk(v, v) & 0xffffu); } }
  }
#undef SLOAD
#undef SWRITE
#undef SWAIT
#undef RESC
}
#undef KSWZ
#undef SBAR
}

namespace att2 {
using att::bf16; using att::bf16x8; using att::f32x16; using att::crow; using att::cvtpk;
constexpr int D = 128, NW = 8, QBLK = 32, KVBLK = 64, LDQ = 2048, LDK = 2048, NSLOT = 3;
constexpr int KSZ = KVBLK * D * 2, VSZ = KVBLK * 256 * 2;
constexpr int OFF_K = 0, OFF_V = NSLOT * KSZ, OFF_W = OFF_V + NSLOT * VSZ, LDS_ATT2 = OFF_W + NW * 256;
#define A2_LAS __attribute__((address_space(3)))

__device__ __forceinline__ void attn_pass(const int PASS, const bf16* __restrict__ Qb, const bf16* __restrict__ Kh, const bf16* __restrict__ Vh,
                                          float* __restrict__ scr, bf16* __restrict__ Ob, const float* __restrict__ gsub, float lam, int seq, char* lds, const float* __restrict__ rope_tab, int t0) {
  int tid = threadIdx.x; asm volatile("" : "+v"(tid));
  const int wid = __builtin_amdgcn_readfirstlane(tid >> 6), lane = tid & 63, r32 = lane & 31, hi = lane >> 5;
  float* wsc = (float*)(lds + OFF_W) + wid * 64; float* li_l = wsc; float* al_l = wsc + 32;
  float m_reg = -1e30f, l_reg = 0; f32x16 o[8] = {}; bf16x8 qr[8];
  const bf16* Qw = Qb + (long)(wid * QBLK + r32) * LDQ + hi * 8;
#pragma unroll
  for (int d0 = 0; d0 < 8; ++d0) qr[d0] = att::ld8(Qw + d0 * 16);
  if (rope_tab) {
    const int t = t0 + wid * QBLK + r32;
#pragma unroll
    for (int a = 0; a < 2; ++a) { const int pos = a ? (t & 63) : (t >> 6);
#pragma unroll
      for (int dd = 0; dd < 2; ++dd) { const att::f32x4v* tp = (const att::f32x4v*)(rope_tab + (pos * 32 + 16 * dd + 8 * hi) * 2);
        const att::u32x4 X1 = __builtin_bit_cast(att::u32x4, qr[4 * a + dd]), X2 = __builtin_bit_cast(att::u32x4, qr[4 * a + dd + 2]); att::u32x4 O1, O2;
#pragma unroll
        for (int e = 0; e < 4; ++e) { const att::f32x4v cs = tp[e];
          const float u1 = __uint_as_float(X1[e] << 16), v1 = __uint_as_float(X1[e] & 0xffff0000u), u2 = __uint_as_float(X2[e] << 16), v2 = __uint_as_float(X2[e] & 0xffff0000u);
          O1[e] = cvtpk(u1 * cs[0] - u2 * cs[1], v1 * cs[2] - v2 * cs[3]); O2[e] = cvtpk(u1 * cs[1] + u2 * cs[0], v1 * cs[3] + v2 * cs[2]); }
        qr[4 * a + dd] = __builtin_bit_cast(bf16x8, O1); qr[4 * a + dd + 2] = __builtin_bit_cast(bf16x8, O2); } }
  }
  int koff[2], voff[2];
#pragma unroll
  for (int i = 0; i < 2; ++i) {
    const int row = (i * 8 + wid) * 4 + (lane >> 4), chunk = (lane & 15) ^ (row & 7); koff[i] = row * LDK + chunk * 8;
    const int st = (i * 8 + wid) * 2 + (lane >> 5), kk = (st >> 2) * 8 + ((lane & 31) >> 2), c = (st & 3) * 32 + (lane & 3) * 8, k = (kk & ~0xC) | ((kk & 4) << 1) | ((kk & 8) >> 1);
    voff[i] = k * LDK + c; }
  const int vb0 = (int)(unsigned)(size_t)(A2_LAS char*)(lds + OFF_V) + att::v_rd_base(lane);
  const int NT = seq / KVBLK;
#define A2_ISSUE_K(t_, s_) do { const bf16* kt_ = Kh + (long)(t_) * KVBLK * LDK; A2_LAS char* kd_ = (A2_LAS char*)(lds + OFF_K) + (s_) * KSZ + wid * 1024; \
    __builtin_amdgcn_global_load_lds((const unsigned*)(kt_ + koff[0]), (A2_LAS unsigned*)(kd_), 16, 0, 0); __builtin_amdgcn_global_load_lds((const unsigned*)(kt_ + koff[1]), (A2_LAS unsigned*)(kd_ + 8192), 16, 0, 0); } while (0)
#define A2_ISSUE_V(t_, s_) do { const bf16* vt_ = Vh + (long)(t_) * KVBLK * LDK; A2_LAS char* vd_ = (A2_LAS char*)(lds + OFF_V) + (s_) * VSZ + wid * 1024; \
    __builtin_amdgcn_global_load_lds((const unsigned*)(vt_ + voff[0]), (A2_LAS unsigned*)(vd_), 16, 0, 0); __builtin_amdgcn_global_load_lds((const unsigned*)(vt_ + voff[1]), (A2_LAS unsigned*)(vd_ + 8192), 16, 0, 0); \
    __builtin_amdgcn_global_load_lds((const unsigned*)(vt_ + 128 + voff[0]), (A2_LAS unsigned*)(vd_ + 16384), 16, 0, 0); __builtin_amdgcn_global_load_lds((const unsigned*)(vt_ + 128 + voff[1]), (A2_LAS unsigned*)(vd_ + 16384 + 8192), 16, 0, 0); } while (0)
  asm volatile("s_waitcnt vmcnt(0) lgkmcnt(0)" ::: "memory"); __builtin_amdgcn_s_barrier(); asm volatile("" ::: "memory");
  A2_ISSUE_K(0, 0); A2_ISSUE_V(0, 0); if (NT > 1) A2_ISSUE_K(1, 1);
  const bool late = wid >= 4;
  int slot = 0; bf16x8 pa0, pa1, pa2, pa3;
#pragma unroll 1
  for (int j = 0; j < NT; ++j) {
    if (j + 1 < NT) asm volatile("s_waitcnt vmcnt(2)" ::: "memory"); else asm volatile("s_waitcnt vmcnt(0)" ::: "memory");
    asm volatile("s_waitcnt lgkmcnt(0)" ::: "memory"); __builtin_amdgcn_s_barrier(); asm volatile("" ::: "memory");
    const int sn = slot == 2 ? 0 : slot + 1, sp_ = slot == 0 ? 2 : slot - 1;
    if (j + 1 < NT) A2_ISSUE_V(j + 1, sn);
    if (j + 2 < NT) A2_ISSUE_K(j + 2, sp_);
    if (late && j > 0) { const int vb = vb0 + sp_ * VSZ; att::pv_d0(o, vb, pa0, pa1, pa2, pa3); att::pv_d0(o + 4, vb + 16384, pa0, pa1, pa2, pa3); }
    f32x16 p0, p1; float mn, al;
    att::qkt(p0, p1, (const bf16*)(lds + OFF_K + slot * KSZ), qr, r32, hi);
    att::partialSM(p0, p1, m_reg, mn, al);
    if (__any(al < 1.f)) { if (hi == 0) al_l[r32] = al; asm volatile("s_waitcnt lgkmcnt(0)" ::: "memory");
#pragma unroll
      for (int d = 0; d < 8; ++d)
#pragma unroll
        for (int r = 0; r < 16; ++r) o[d][r] *= al_l[crow(r, hi)]; }
    att::finishSM(p0, p1, al, l_reg, pa0, pa1, pa2, pa3);
    __builtin_amdgcn_sched_barrier(0);
    if (!late) { const int vb = vb0 + slot * VSZ; att::pv_d0(o, vb, pa0, pa1, pa2, pa3); att::pv_d0(o + 4, vb + 16384, pa0, pa1, pa2, pa3); }
    slot = sn;
  }
  if (late) { const int sl = slot == 0 ? 2 : slot - 1; const int vb = vb0 + sl * VSZ; att::pv_d0(o, vb, pa0, pa1, pa2, pa3); att::pv_d0(o + 4, vb + 16384, pa0, pa1, pa2, pa3); }
#undef A2_ISSUE_K
#undef A2_ISSUE_V
  if (hi == 0) li_l[r32] = l_reg; asm volatile("s_waitcnt lgkmcnt(0)" ::: "memory");
  float rli[16];
#pragma unroll
  for (int r = 0; r < 16; ++r) rli[r] = __builtin_amdgcn_rcpf(li_l[crow(r, hi)]);
  unsigned* sp = (unsigned*)scr + tid * 64;
  if (PASS == 0) {
#pragma unroll
    for (int d0 = 0; d0 < 8; ++d0)
#pragma unroll
      for (int r8 = 0; r8 < 2; ++r8) { const int r = 8 * r8;
        *(att::u32x4*)(sp + d0 * 8 + r8 * 4) = (att::u32x4){cvtpk(o[d0][r] * rli[r], o[d0][r + 1] * rli[r + 1]), cvtpk(o[d0][r + 2] * rli[r + 2], o[d0][r + 3] * rli[r + 3]),
                                                             cvtpk(o[d0][r + 4] * rli[r + 4], o[d0][r + 5] * rli[r + 5]), cvtpk(o[d0][r + 6] * rli[r + 6], o[d0][r + 7] * rli[r + 7])}; }
  } else {
    asm volatile("s_waitcnt lgkmcnt(0)" ::: "memory"); __builtin_amdgcn_s_barrier(); asm volatile("" ::: "memory");
    A2_LAS att::u32x4* lv = (A2_LAS att::u32x4*)((A2_LAS char*)lds + wid * 17408 + lane * 272);
    float ssq[16];
#pragma unroll
    for (int r = 0; r < 16; ++r) { ssq[r] = 0.f; rli[r] *= lam; }
#pragma unroll
    for (int d0 = 0; d0 < 8; ++d0)
#pragma unroll
      for (int r8 = 0; r8 < 2; ++r8) { const att::u32x4 s4 = *(const att::u32x4*)(sp + d0 * 8 + r8 * 4); att::u32x4 w4;
#pragma unroll
        for (int e = 0; e < 4; ++e) { const int r = 8 * r8 + 2 * e;
          const float v0 = __uint_as_float(s4[e] << 16) - o[d0][r] * rli[r], v1 = __uint_as_float(s4[e] & 0xffff0000u) - o[d0][r + 1] * rli[r + 1];
          ssq[r] = fmaf(v0, v0, ssq[r]); ssq[r + 1] = fmaf(v1, v1, ssq[r + 1]); w4[e] = cvtpk(v0, v1); }
        lv[d0 * 2 + r8] = w4; }
#pragma unroll
    for (int r = 0; r < 16; ++r) {
      float s = ssq[r]; s += __shfl_xor(s, 1); s += __shfl_xor(s, 2); s += __shfl_xor(s, 4); s += __shfl_xor(s, 8); s += __shfl_xor(s, 16);
      ssq[r] = 0.8f / sqrtf(s * (1.f / 256.f) + 1e-6f); }
    float gs8[8];
#pragma unroll
    for (int d0 = 0; d0 < 8; ++d0) gs8[d0] = gsub[d0 * 32 + r32];
    const int lofs = hi * 4 * 4096 + r32;
    __attribute__((address_space(1))) bf16* rowb = (__attribute__((address_space(1))) bf16*)(Ob + (long)(wid * QBLK) * 4096); asm volatile("" : "+s"(rowb));
#pragma unroll
    for (int d0 = 0; d0 < 8; ++d0) { const float g = gs8[d0];
#pragma unroll
      for (int r8 = 0; r8 < 2; ++r8) { const att::u32x4 w4 = lv[d0 * 2 + r8];
#pragma unroll
        for (int e = 0; e < 4; ++e) { const int r = 8 * r8 + 2 * e;
          const float v0 = __uint_as_float(w4[e] << 16) * ssq[r] * g, v1 = __uint_as_float(w4[e] & 0xffff0000u) * ssq[r + 1] * g;
          rowb[(long)((r & 3) + 8 * (r >> 2)) * 4096 + lofs + d0 * 32] = (bf16)(cvtpk(v0, v0) & 0xffffu);
          rowb[(long)(((r + 1) & 3) + 8 * ((r + 1) >> 2)) * 4096 + lofs + d0 * 32] = (bf16)(cvtpk(v1, v1) & 0xffffu); } } }
  }
}
#undef A2_LAS
}

constexpr int NWAVES = 8;
#ifndef PROBE_DUP
#define PROBE_DUP -1
#endif
constexpr int DM = 4096, MP = 8192, MS = 16384, MT = 24576;
constexpr int NINB = 7424;
constexpr int DFF = 16384, MLP_CH = 8192, N_MLP_CH = MT / MLP_CH;
constexpr int KVS = 4608;
constexpr float RMS_EPS = 1e-6f;
constexpr size_t MiB = 1u << 20;
constexpr size_t WS_CTL = 0, CTL_ZERO_BYTES = 1 * MiB;
constexpr size_t WS_MOD = 1 * MiB;
constexpr size_t WS_ROPE = 1 * MiB + 768 * 1024;
constexpr size_t WS_DEC = 1 * MiB + 512 * 1024;
constexpr size_t WS_PART = 2 * MiB;
constexpr size_t WS_WIN = 32 * MiB, WS_WOUT = 122 * MiB, WS_WUP = 154 * MiB, WS_WDN = 282 * MiB;
constexpr size_t WS_H = 410 * MiB;
constexpr size_t WS_ASCR = 410 * MiB;
constexpr size_t WS_Q = 602 * MiB, WS_KP = 698 * MiB, WS_KS = 730 * MiB, WS_VP = 802 * MiB, WS_VS = 834 * MiB, WS_Z = 906 * MiB;
constexpr size_t WS_XR = 1002 * MiB, WS_XC = 1146 * MiB, WS_DT = 1290 * MiB, WS_CAT = 1296 * MiB, WS_END = 1488 * MiB;
constexpr size_t WS_WINQ = 218 * MiB;
constexpr size_t WS_HQ = WS_CAT;
constexpr size_t WS_RST = 2 * MiB + 512 * 1024;
constexpr size_t WS_CATQ = WS_XR;
constexpr size_t WS_LMW = 122 * MiB;
constexpr size_t WS_WOUTQ = 90 * MiB;
constexpr size_t WS_X1 = WS_CAT;
constexpr size_t WS_MIX = 602 * MiB, WS_UP = 602 * MiB, WS_MOUT = 922 * MiB, WS_UPQ = 1114 * MiB;
constexpr int CW_BAR = 4096;
constexpr size_t WS_FOLD = 512 * 1024;
constexpr int CW_RMAX = 32768, CW_CMAX = 65536, CW_CS = 69632, CW_CMAXU = 73728, CW_CMAXI = 94208, CW_CMAXO = 106496;
constexpr size_t WS_SA = 2 * MiB, WS_SAH = 2 * MiB + 128 * 1024, WS_SB = 1 * MiB + 896 * 1024, WS_SBU = 1 * MiB + 912 * 1024, WS_SBI = 1 * MiB + 976 * 1024, WS_SAHI = 2 * MiB + 384 * 1024, WS_SBO = 1 * MiB + 576 * 1024, WS_SAC = 2 * MiB + 256 * 1024;
constexpr size_t O_YP = 0, O_YS = (size_t)MP * DM, O_NK = O_YS + (size_t)MS * DM, O_NV = O_NK + (size_t)MP * 2048, O_SF = O_NV + (size_t)MP * 2048, O_SB = O_SF + (size_t)32 * 32 * 64 * 128;
constexpr size_t OUT_TOTAL = O_SB + (size_t)32 * 32 * 64 * 128;
constexpr int LDS_BYTES = 163840, LDSCTL_OFF = LDS_BYTES - 512, MISC_OFF = LDSCTL_OFF + 320;

#define GAS __attribute__((address_space(1)))
#define LAS __attribute__((address_space(3)))
typedef unsigned short bf16;
typedef unsigned v4u __attribute__((ext_vector_type(4)));
typedef unsigned v2u __attribute__((ext_vector_type(2)));
typedef float f32x4 __attribute__((ext_vector_type(4)));
typedef short bf16x8 __attribute__((ext_vector_type(8)));
#define LDS_WAIT() asm volatile("s_waitcnt lgkmcnt(0)" ::: "memory")
#define VM_WAIT() asm volatile("s_waitcnt vmcnt(0)" ::: "memory")
__device__ __forceinline__ unsigned pkbf(float lo, float hi) { unsigned r; asm("v_cvt_pk_bf16_f32 %0, %1, %2" : "=v"(r) : "v"(lo), "v"(hi)); return r; }
__device__ __forceinline__ float bflo(unsigned u) { return __uint_as_float(u << 16); }
__device__ __forceinline__ float bfhi(unsigned u) { return __uint_as_float(u & 0xffff0000u); }
__device__ __forceinline__ float wave_sum(float v) {
#pragma unroll
    for (int o = 1; o < 64; o <<= 1) v += __shfl_xor(v, o);
    return v;
}
__device__ __forceinline__ float wave_incl_scan(float v, int lane) {
#pragma unroll
    for (int o = 1; o < 64; o <<= 1) { const float t = __shfl_up(v, o); if (lane >= o) v += t; }
    return v;
}
__device__ __forceinline__ float silu_f(float x) { return x / (1.f + __expf(-x)); }

static_assert(WS_UP + (size_t)MLP_CH * DFF * 2 <= WS_MOUT && WS_UPQ + (size_t)MLP_CH * DFF <= WS_CAT, "MLP buffers");
#define XB_TMO      128
#define XB_XCNT(j)  (256  + 64 * (j))
#define XB_XSUB(j)  (1280 + 64 * (j))
#define XB_XGEN(j)  (2304 + 64 * (j))
#define XB_TOP      3328
#define XB_TOPGEN   3392
#define XCD_BAR_WORDS 3456
#define XB_SPIN_CAP (1u << 18)

__device__ __forceinline__ unsigned xb_ld(unsigned* p)              { return __hip_atomic_load(p, __ATOMIC_RELAXED, __HIP_MEMORY_SCOPE_AGENT); }
__device__ __forceinline__ unsigned xb_add(unsigned* p, unsigned v) { return __hip_atomic_fetch_add(p, v, __ATOMIC_RELAXED, __HIP_MEMORY_SCOPE_AGENT); }
__device__ __forceinline__ unsigned xb_xcc_id() { return (unsigned)__builtin_amdgcn_s_getreg((3 << 11) | 20) & 0xFu; }
#define XB_SPIN(cond, bar) do { unsigned _sp = 0; while (cond) { __builtin_amdgcn_s_sleep(1); \
    if ((++_sp & 255u) == 0u) { if (xb_ld(&(bar)[XB_TMO])) break; if (_sp > XB_SPIN_CAP) { atomicAdd(&(bar)[XB_TMO], 1u); break; } } } } while (0)

struct XcdBarrier {
    unsigned* bar; unsigned x;
    volatile LAS unsigned* st;
};

__device__ __forceinline__ XcdBarrier xcd_barrier_post(unsigned* bar, volatile LAS unsigned* st) {
    XcdBarrier b; b.bar = bar; b.x = xb_xcc_id(); b.st = st;
    if (threadIdx.x == 0) (void)xb_add(&bar[XB_XCNT(b.x)], 1u);
    return b;
}
__device__ __forceinline__ void xcd_barrier_complete(unsigned* bar, unsigned x, unsigned& nloc, unsigned& nx) {
    const unsigned G = gridDim.x * gridDim.y * gridDim.z;
    unsigned sum, cnt, mine, sp = 0u;
    for (;;) {
        sum = 0u; cnt = 0u; mine = 0u;
#pragma unroll
        for (unsigned j = 0; j < 16; ++j) { const unsigned c = xb_ld(&bar[XB_XCNT(j)]); sum += c; cnt += (c > 0u) ? 1u : 0u; mine = (j == x) ? c : mine; }
        if (sum == G) break;
        __builtin_amdgcn_s_sleep(1);
        if ((++sp & 255u) == 0u) { if (xb_ld(&bar[XB_TMO])) break; if (sp > XB_SPIN_CAP) { atomicAdd(&bar[XB_TMO], 1u); break; } }
    }
    nloc = mine > 0u ? mine : 1u; nx = cnt > 0u ? cnt : 1u;
}

__device__ __forceinline__ void xcd_barrier(const XcdBarrier& b) {
    asm volatile("s_waitcnt vmcnt(0)" ::: "memory");
    __syncthreads();
    if (threadIdx.x == 0) {
        unsigned* bar = b.bar;
        __builtin_amdgcn_s_waitcnt(0);
        unsigned nloc = b.st[0], nx = b.st[1];
        if (nloc == 0u) { xcd_barrier_complete(bar, b.x, nloc, nx); b.st[0] = nloc; b.st[1] = nx; }
        const unsigned old = xb_add(&bar[XB_XSUB(b.x)], 1u);
        const unsigned gen = old / nloc;
        if (old + 1u == (gen + 1u) * nloc) {
            __builtin_amdgcn_fence(__ATOMIC_RELEASE, "agent");
            asm volatile("s_waitcnt vmcnt(0)" ::: "memory");
            const unsigned og = xb_add(&bar[XB_TOP], 1u);
            const unsigned tg = og / nx;
            if (og + 1u == (tg + 1u) * nx) xb_add(&bar[XB_TOPGEN], 1u);
            else XB_SPIN(xb_ld(&bar[XB_TOPGEN]) == tg, bar);
            __builtin_amdgcn_fence(__ATOMIC_ACQUIRE, "agent");
            xb_add(&bar[XB_XGEN(b.x)], 1u);
            asm volatile("s_waitcnt vmcnt(0)" ::: "memory");
        } else {
            XB_SPIN(xb_ld(&bar[XB_XGEN(b.x)]) == gen, bar);
            __builtin_amdgcn_fence(__ATOMIC_ACQUIRE, "agent");
            asm volatile("s_waitcnt vmcnt(0)" ::: "memory");
        }
    }
    __syncthreads();
}
struct Args { const float* in[29]; float* out; unsigned char* ws; int ph_lo, ph_hi; };
static_assert(sizeof(Args) == 29 * 8 + 8 + 8 + 8, "Args has no padding");
typedef const __attribute__((address_space(4))) Args CArgs;
#define ARGS_PTR() ({ CArgs* _a = (CArgs*)__builtin_amdgcn_kernarg_segment_ptr(); asm volatile("" : "+s"(_a)); _a; })
struct Frame {
    LAS unsigned char* lds;
    int tid, lane, wave, vcu, G;
};

#define Q4_MAGIC(v0, v1, v2, v3, s) __builtin_amdgcn_perm(__builtin_amdgcn_perm(__float_as_uint(fmaf((v3), (s), 12582912.f)), __float_as_uint(fmaf((v2), (s), 12582912.f)), 0x0c0c0400u), \
                                                          __builtin_amdgcn_perm(__float_as_uint(fmaf((v1), (s), 12582912.f)), __float_as_uint(fmaf((v0), (s), 12582912.f)), 0x0c0c0400u), 0x05040100u)
__device__ __forceinline__ void p0_transpose_item(const float* W, int K, int N, bf16* WT, LAS float* scr, int kb, int n0, int d0, int lane) {
    const int k0 = 64 * kb;
#pragma unroll 8
    for (int i = 0; i < 32; ++i) { const int kk = 2 * i + (lane >> 5); scr[kk * 33 + (lane & 31)] = W[(size_t)(k0 + kk) * N + n0 + (lane & 31)]; }
    LDS_WAIT(); asm volatile("" ::: "memory");
    const int c = lane & 7;
#pragma unroll
    for (int j = 0; j < 4; ++j) { const int n = (lane >> 3) + 8 * j; const LAS float* s = scr + (8 * c) * 33 + n;
        v4u o; o.x = pkbf(s[0 * 33], s[1 * 33]); o.y = pkbf(s[2 * 33], s[3 * 33]); o.z = pkbf(s[4 * 33], s[5 * 33]); o.w = pkbf(s[6 * 33], s[7 * 33]);
        *(GAS v4u*)(WT + (size_t)(d0 + n) * K + k0 + 8 * c) = o; }
    LDS_WAIT(); asm volatile("" ::: "memory");
}
template <bool ROT> __device__ __forceinline__ float tile_rot64(LAS float* scr, int lane) {
    const int n = lane & 31, kh = lane >> 5; float v[32];
#pragma unroll
    for (int i = 0; i < 32; ++i) v[i] = scr[(32 * kh + i) * 33 + n];
    if (ROT) {
#pragma unroll
        for (int s = 1; s < 32; s <<= 1)
#pragma unroll
            for (int i = 0; i < 32; ++i) if (!(i & s)) { const float a = v[i], b = v[i | s]; v[i] = a + b; v[i | s] = a - b; }
#pragma unroll
        for (int i = 0; i < 32; ++i) { const float o = __shfl_xor(v[i], 32); v[i] = (kh ? o - v[i] : v[i] + o) * 0.125f; }
#pragma unroll
        for (int i = 0; i < 32; ++i) scr[(32 * kh + i) * 33 + n] = v[i];
        LDS_WAIT(); asm volatile("" ::: "memory");
    }
    float mx = 0.f;
#pragma unroll
    for (int i = 0; i < 32; ++i) mx = fmaxf(mx, fabsf(v[i]));
    return fmaxf(mx, __shfl_xor(mx, 32));
}
__device__ __forceinline__ void ada_item(Frame& F, CArgs* A, int it, int lane_) {
    const int lane = lane_, kc = it / 96, cb = it % 96, k0 = kc * 64, n0 = cb * 256 + lane * 4;
    float cv[5];
    cv[0] = silu_f((A->in[7])[k0 + lane]);
#pragma unroll
    for (int v = 1; v < 5; ++v) cv[v] = silu_f((A->in[2])[(v - 1) * DM + k0 + lane]);
    f32x4 acc[5];
#pragma unroll
    for (int v = 0; v < 5; ++v) acc[v] = (f32x4){0.f, 0.f, 0.f, 0.f};
    const float* wp = (A->in[8]) + (size_t)k0 * 24576 + n0;
#pragma unroll
    for (int kh = 0; kh < 2; ++kh) { f32x4 w[32];
#pragma unroll
        for (int kk = 0; kk < 32; ++kk) w[kk] = *(const GAS f32x4*)(wp + (size_t)(32 * kh + kk) * 24576);
#pragma unroll
        for (int kk = 0; kk < 32; ++kk)
#pragma unroll
            for (int v = 0; v < 5; ++v) { const float s = __builtin_bit_cast(float, __builtin_amdgcn_readlane(__builtin_bit_cast(int, cv[v]), 32 * kh + kk)); acc[v] += w[kk] * s; } }
#pragma unroll
    for (int v = 0; v < 5; ++v) *(GAS f32x4*)(((float*)(A->ws + WS_PART)) + (size_t)(kc * 5 + v) * 24576 + n0) = acc[v];
}
__device__ __forceinline__ void p0_prologue(Frame& F) {
    CArgs* A = ARGS_PTR(); int tid_ = (int)threadIdx.x; asm volatile("" : "+v"(tid_)); const int lane_ = tid_ & 63;
    LAS float* scr = (LAS float*)(F.lds + F.wave * 16384);
    const int gw = F.vcu * NWAVES + F.wave, NGW = F.G * NWAVES;
    const int gt = F.vcu * 512 + tid_, NT = F.G * 512;
    for (int it = gw; it < 64 * 96; it += NGW) ada_item(F, A, it, lane_);
    constexpr int NB_IN = 98, I_IN = 64 * NB_IN, I_OUT = 64 * 128;
    for (int it = gw; it < I_IN + I_OUT; it += NGW) {
        if (it < I_IN) { const int kb = it / NB_IN, nbv = it - kb * NB_IN, n0 = 8192 + 32 * nbv;
            p0_transpose_item((A->in[14]), DM, 11328, ((bf16*)(A->ws + WS_WIN)), scr, kb, n0, n0 - 4096, lane_); }
        else { const int r = it - I_IN, kb = r >> 7, nb = r & 127, k0 = 64 * kb, n0 = 32 * nb; const float* W = A->in[26];
#pragma unroll 8
            for (int i = 0; i < 32; ++i) { const int kk = 2 * i + (lane_ >> 5); scr[kk * 33 + (lane_ & 31)] = W[(size_t)(k0 + kk) * DM + n0 + (lane_ & 31)]; }
            LDS_WAIT(); asm volatile("" ::: "memory");
            const float mx = tile_rot64<true>(scr, lane_);
            if (lane_ < 32) __hip_atomic_fetch_max((unsigned*)(A->ws + WS_CTL) + CW_CMAXO + n0 + lane_, __float_as_uint(mx), __ATOMIC_RELAXED, __HIP_MEMORY_SCOPE_AGENT);
            LDS_WAIT(); asm volatile("" ::: "memory"); }
    }
    {   unsigned* cmax = (unsigned*)(A->ws + WS_CTL) + CW_CMAXI; const float* wi = A->in[14];
        for (int it = gw; it < 64 * 44; it += NGW) { const int kb = it / 44, cb = it - kb * 44, v0 = cb * 256; const float* wp = wi + (size_t)(kb * 64) * 11328 + (v0 < 2048 ? v0 : (v0 < 4096 ? v0 + 4096 : (v0 < 8192 ? v0 - 2048 : v0))) + lane_ * 4;
            f32x4 mx = (f32x4){0.f, 0.f, 0.f, 0.f};
#pragma unroll 16
            for (int kk = 0; kk < 64; ++kk) { const f32x4 w = *(const GAS f32x4*)(wp + (size_t)kk * 11328); mx = (f32x4){fmaxf(mx[0], fabsf(w[0])), fmaxf(mx[1], fabsf(w[1])), fmaxf(mx[2], fabsf(w[2])), fmaxf(mx[3], fabsf(w[3]))}; }
#pragma unroll
            for (int e = 0; e < 4; ++e) __hip_atomic_fetch_max(cmax + cb * 256 + lane_ * 4 + e, __float_as_uint(mx[e]), __ATOMIC_RELAXED, __HIP_MEMORY_SCOPE_AGENT); }
    }
    {
#define P0_SRC(item_, wp_, ldw_) do { const int w_ = (item_) >= 32768, it_ = (item_) - w_ * 32768; const int N_ = w_ ? DFF : DM, nblk_ = N_ / 32, kb_ = it_ / nblk_, n0_ = 32 * (it_ - kb_ * nblk_); \
            ldw_ = N_; wp_ = (w_ ? A->in[27] : A->in[28]) + (size_t)(64 * kb_ + (lane_ >> 5)) * ldw_ + n0_ + (lane_ & 31); } while (0)
        constexpr int P0_ITEMS = 2 * 32768;
        float tl[32];
        if (gw < P0_ITEMS) { const float* wp; int ldw; P0_SRC(gw, wp, ldw);
#pragma unroll
            for (int i = 0; i < 32; ++i) tl[i] = wp[(size_t)(2 * i) * ldw]; }
#pragma unroll 1
        for (int item = gw; item < P0_ITEMS; item += NGW) {
            const int which = item >= 32768, it = item - which * 32768;
            const int K = which ? DM : DFF, N = which ? DFF : DM, nblk = N / 32, kb = it / nblk, nb = it - kb * nblk, k0 = 64 * kb, n0 = 32 * nb;
            unsigned char* WQ = (unsigned char*)(A->ws + (which ? WS_WUP : WS_WDN)); float* LM = (float*)(A->ws + WS_LMW + (which ? 4 * MiB : 0));
#pragma unroll
            for (int i = 0; i < 32; ++i) scr[(2 * i + (lane_ >> 5)) * 33 + (lane_ & 31)] = tl[i];
            asm volatile("" ::: "memory");
            {   const int nx = item + NGW < P0_ITEMS ? item + NGW : P0_ITEMS - 1; const float* wp; int ldw; P0_SRC(nx, wp, ldw);
#pragma unroll
                for (int i = 0; i < 32; ++i) tl[i] = wp[(size_t)(2 * i) * ldw]; }
            LDS_WAIT(); asm volatile("" ::: "memory");
            const int c = lane_ & 7;
#pragma unroll
            for (int j = 0; j < 4; ++j) { const int n = (lane_ >> 3) + 8 * j; const LAS float* s = scr + (8 * c) * 33 + n;
                float w8[8], lm = 0.f;
#pragma unroll
                for (int e = 0; e < 8; ++e) { w8[e] = s[e * 33]; lm = fmaxf(lm, fabsf(w8[e])); }
                lm = fmaxf(lm, __shfl_xor(lm, 1)); lm = fmaxf(lm, __shfl_xor(lm, 2)); lm = fmaxf(lm, __shfl_xor(lm, 4));
                const float inv = lm > 0.f ? 127.f / lm : 0.f; unsigned lo = 0u, hi = 0u;
#pragma unroll
                for (int e = 0; e < 4; ++e) { lo |= (unsigned)(__float2int_rn(w8[e] * inv) & 0xff) << (8 * e); hi |= (unsigned)(__float2int_rn(w8[4 + e] * inv) & 0xff) << (8 * e); }
                *(GAS v2u*)(WQ + (size_t)(n0 + n) * K + k0 + 8 * c) = (v2u){lo, hi};
                LM[(size_t)(n0 + n) * (K >> 6) + kb] = lm; }
            LDS_WAIT(); asm volatile("" ::: "memory");
        }
#undef P0_SRC
    }
    for (int i = gt; i < 64 * 32; i += NT) { const float inv = exp2f(-(float)(2 * (i & 31)) * (13.287712379549449f / 64.f)); float s, c; sincosf((float)(i >> 5) * inv, &s, &c); ((float*)(A->ws + WS_ROPE))[2 * i] = c; ((float*)(A->ws + WS_ROPE))[2 * i + 1] = s; }
    for (int i = gt; i < 192 * DM / 8; i += NT) *(GAS v4u*)(((bf16*)(A->ws + WS_WIN)) + (size_t)7232 * DM + (size_t)i * 8) = (v4u){0u, 0u, 0u, 0u};
    for (int i = gt; i < 2 * 524288; i += NT) { const int which = i >= 524288, j = i - which * 524288, row = j >> 8, c8 = (j & 255) * 8, b = row >> 9, t = row & 511;
        const float* src = (which ? (A->in[4]) : (A->in[3])) + (size_t)row * 2048 + c8; const f32x4 a = *(const GAS f32x4*)src, bb = *(const GAS f32x4*)(src + 4);
        v4u o; o.x = pkbf(a[0], a[1]); o.y = pkbf(a[2], a[3]); o.z = pkbf(bb[0], bb[1]); o.w = pkbf(bb[2], bb[3]);
        *(GAS v4u*)((which ? ((bf16*)(A->ws + WS_VS)) : ((bf16*)(A->ws + WS_KS))) + ((size_t)b * KVS + t) * 2048 + c8) = o; }
}
__device__ __forceinline__ void p1_mod(Frame& F) {
    CArgs* A = ARGS_PTR(); int tid_ = (int)threadIdx.x; asm volatile("" : "+v"(tid_)); const int lane_ = tid_ & 63;
    const int gt = F.vcu * 512 + tid_, NT = F.G * 512;
    for (int i = gt; i < 5 * 24576; i += NT) { const int v = i / 24576, n = i - v * 24576; float s = (A->in[9])[n];
#pragma unroll 8
        for (int kc = 0; kc < 64; ++kc) s += ((float*)(A->ws + WS_PART))[(size_t)(kc * 5 + v) * 24576 + n];
        ((float*)(A->ws + WS_MOD))[i] = s;
        {   const int ch = n >> 12, c = n & 4095; float* fo = (float*)(A->ws + WS_FOLD) + (size_t)v * 16384 + c;
            if (ch == 1) fo[0] = (A->in[10])[c] * (1.f + s); else if (ch == 2) fo[4096] = s * (A->in[11])[c]; else if (ch == 4) fo[8192] = (A->in[12])[c] * (1.f + s); else if (ch == 5) fo[12288] = s * (A->in[13])[c]; } }
    {   LAS float* scr = (LAS float*)(F.lds + F.wave * 16384);
        const int gw = F.vcu * NWAVES + F.wave, NGW = F.G * NWAVES, lane = lane_;
#define P1_SRC(item_, wp_, ldw_) do { const int w_ = (item_) >= 88064 ? 3 : ((item_) >= 65536 ? 2 : ((item_) >= 32768 ? 1 : 0)), it_ = (item_) - (w_ == 3 ? 88064 : w_ * 32768); \
            const int N_ = w_ == 1 ? DFF : (w_ == 2 ? 11264 : DM), nblk_ = N_ / 32, kb_ = it_ / nblk_, n0_ = 32 * (it_ - kb_ * nblk_); \
            ldw_ = w_ == 2 ? 11328 : N_; const int coff_ = w_ != 2 ? 0 : (n0_ < 2048 ? 0 : (n0_ < 4096 ? 4096 : (n0_ < 8192 ? -2048 : 0))); \
            wp_ = (w_ == 0 ? A->in[28] : (w_ == 1 ? A->in[27] : (w_ == 2 ? A->in[14] : A->in[26]))) + (size_t)(64 * kb_ + (lane >> 5)) * ldw_ + coff_ + n0_ + (lane & 31); } while (0)
        constexpr int P1_ITEMS = 2 * 32768 + 22528 + 8192;
        float tl[32];
        constexpr int P1_FIRST = 2 * 32768;
        if (P1_FIRST + gw < P1_ITEMS) { const float* wp; int ldw; P1_SRC(P1_FIRST + gw, wp, ldw);
#pragma unroll
            for (int i = 0; i < 32; ++i) tl[i] = wp[(size_t)(2 * i) * ldw]; }
#pragma unroll 1
        for (int item = P1_FIRST + gw; item < P1_ITEMS; item += NGW) {
            const int which = item >= 88064 ? 3 : (item >= 65536 ? 2 : (item >= 32768 ? 1 : 0)); const bool up = which != 0; const int it = item - (which == 3 ? 88064 : which * 32768);
            const int K = which == 0 ? DFF : DM, N = which == 1 ? DFF : (which == 2 ? 11264 : DM), nblk = N / 32, kb = it / nblk, nb = it - kb * nblk, k0 = 64 * kb, n0 = 32 * nb;
            unsigned char* WQ = (unsigned char*)(A->ws + (which == 0 ? WS_WDN : (which == 1 ? WS_WUP : (which == 2 ? WS_WINQ : WS_WOUTQ))));
            const unsigned* cmax = (const unsigned*)(A->ws + WS_CTL) + (which == 0 ? CW_CMAX : (which == 1 ? CW_CMAXU : (which == 2 ? CW_CMAXI : CW_CMAXO))); float* SB = (float*)(A->ws + (which == 0 ? WS_SB : (which == 1 ? WS_SBU : (which == 2 ? WS_SBI : WS_SBO)))); int* CS = (int*)(A->ws + WS_CTL) + CW_CS;
#pragma unroll
            for (int i = 0; i < 32; ++i) scr[(2 * i + (lane >> 5)) * 33 + (lane & 31)] = tl[i];
            float cmj[4];
#pragma unroll
            for (int j = 0; j < 4; ++j) cmj[j] = __uint_as_float(cmax[n0 + (lane >> 3) + 8 * j]);
            asm volatile("" ::: "memory");
            {   const int nx = item + NGW < P1_ITEMS ? item + NGW : P1_ITEMS - 1;
                const float* wp; int ldw; P1_SRC(nx, wp, ldw);
#pragma unroll
                for (int i = 0; i < 32; ++i) tl[i] = wp[(size_t)(2 * i) * ldw]; }
            LDS_WAIT(); asm volatile("" ::: "memory");
            if (which == 3) (void)tile_rot64<true>(scr, lane);
            const int c = lane & 7;
#pragma unroll
            for (int j = 0; j < 4; ++j) { const int n = (lane >> 3) + 8 * j; const LAS float* s = scr + (8 * c) * 33 + n;
                const float cm = cmj[j], inv = cm > 0.f ? 127.f / cm : 0.f;
                int q[8], sum = 0;
#pragma unroll
                for (int e = 0; e < 8; ++e) { int t = __float2int_rn(s[e * 33] * inv); t = t > 127 ? 127 : (t < -127 ? -127 : t); q[e] = t; sum += t; }
                const unsigned lo = (unsigned)(q[0] & 0xff) | ((unsigned)(q[1] & 0xff) << 8) | ((unsigned)(q[2] & 0xff) << 16) | ((unsigned)(q[3] & 0xff) << 24);
                const unsigned hi = (unsigned)(q[4] & 0xff) | ((unsigned)(q[5] & 0xff) << 8) | ((unsigned)(q[6] & 0xff) << 16) | ((unsigned)(q[7] & 0xff) << 24);
                *(GAS v2u*)(WQ + (size_t)(n0 + n) * K + k0 + 8 * c) = (v2u){lo, hi};
                sum += __shfl_xor(sum, 1); sum += __shfl_xor(sum, 2); sum += __shfl_xor(sum, 4);
                if (c == 0) { if (!up) __hip_atomic_fetch_add(CS + n0 + n, sum, __ATOMIC_RELAXED, __HIP_MEMORY_SCOPE_AGENT); if (kb == 0) SB[n0 + n] = cm * (1.f / 127.f); } }
            LDS_WAIT(); asm volatile("" ::: "memory");
        }
#undef P1_SRC
#define WQ_ROW4(rowp_, lmp_, ci_, sum_) do { v4u v_[4]; float lm_[4]; \
            _Pragma("unroll") for (int j = 0; j < 4; ++j) { v_[j] = *(const GAS v4u*)((rowp_) + j * 1024 + 16 * lane); lm_[j] = (lmp_)[16 * j + (lane >> 2)]; } \
            _Pragma("unroll") for (int j = 0; j < 4; ++j) { const float ratio = lm_[j] * (ci_); v4u o_; \
                _Pragma("unroll") for (int e = 0; e < 4; ++e) { const unsigned x = v_[j][e]; \
                    const int q0 = __float2int_rn((float)((int)(x << 24) >> 24) * ratio), q1 = __float2int_rn((float)((int)(x << 16) >> 24) * ratio), q2 = __float2int_rn((float)((int)(x << 8) >> 24) * ratio), q3 = __float2int_rn((float)((int)x >> 24) * ratio); \
                    o_[e] = (unsigned)(q0 & 0xff) | ((unsigned)(q1 & 0xff) << 8) | ((unsigned)(q2 & 0xff) << 16) | ((unsigned)q3 << 24); \
                    sum_ = __builtin_amdgcn_sad_u8(o_[e] ^ 0x80808080u, 0u, sum_); }                        \
                *(GAS v4u*)((rowp_) + j * 1024 + 16 * lane) = o_; } } while (0)
#pragma unroll 1
        for (int r = gw; r < 4096; r += NGW) {
            unsigned char* rowp = (unsigned char*)(A->ws + WS_WDN) + (size_t)r * DFF; const float* lmp = (const float*)(A->ws + WS_LMW) + (size_t)r * 256;
            float cm = fmaxf(fmaxf(lmp[lane], lmp[64 + lane]), fmaxf(lmp[128 + lane], lmp[192 + lane]));
#pragma unroll
            for (int o = 1; o < 64; o <<= 1) cm = fmaxf(cm, __shfl_xor(cm, o));
            const float ci = cm > 0.f ? 1.f / cm : 0.f; unsigned sum = 0u;
#pragma unroll 1
            for (int qd = 0; qd < 4; ++qd) { WQ_ROW4(rowp + qd * 4096, lmp + qd * 64, ci, sum); }
#pragma unroll
            for (int o = 1; o < 64; o <<= 1) sum += __shfl_xor(sum, o);
            if (lane == 0) { ((int*)(A->ws + WS_CTL))[CW_CS + r] = (int)sum - 128 * DFF; ((float*)(A->ws + WS_SB))[r] = cm * (1.f / 127.f); } }
#pragma unroll 1
        for (int r = gw; r < 16384; r += NGW) {
            unsigned char* rowp = (unsigned char*)(A->ws + WS_WUP) + (size_t)r * DM; const float* lmp = (const float*)(A->ws + WS_LMW + 4 * MiB) + (size_t)r * 64;
            float cm = lmp[lane];
#pragma unroll
            for (int o = 1; o < 64; o <<= 1) cm = fmaxf(cm, __shfl_xor(cm, o));
            const float ci = cm > 0.f ? 1.f / cm : 0.f; unsigned sum = 0u;
            WQ_ROW4(rowp, lmp, ci, sum); (void)sum;
            if (lane == 0) ((float*)(A->ws + WS_SBU))[r] = cm * (1.f / 127.f); }
#undef WQ_ROW4
    }
}
__device__ __forceinline__ void p11_requant(Frame& F, const int ch, unsigned char* UPQb, const float* LMb) {
    CArgs* A = ARGS_PTR(); int tid_ = (int)threadIdx.x; asm volatile("" : "+v"(tid_)); const int lane = tid_ & 63;
    const int gw = F.vcu * NWAVES + F.wave, NGW = F.G * NWAVES;
    float* SA = (float*)(A->ws + WS_SA) + ch * MLP_CH;
    const int lidx = 4 * (lane >> 4) + ((lane >> 1) & 3);
#pragma unroll 1
    for (int r = gw; r < MLP_CH; r += NGW) {
        unsigned char* rowp = UPQb + (size_t)r * DFF + 16 * lane; const float* lmp = LMb + (size_t)r * 256 + lidx;
        v4u v[16]; float lm[16];
#pragma unroll
        for (int j = 0; j < 16; ++j) { v[j] = *(const GAS v4u*)(rowp + j * 1024); lm[j] = lmp[16 * j]; }
        float gm = 0.f;
#pragma unroll
        for (int j = 0; j < 16; ++j) gm = fmaxf(gm, lm[j]);
#pragma unroll
        for (int o = 1; o < 64; o <<= 1) gm = fmaxf(gm, __shfl_xor(gm, o));
        const float ginv = gm > 0.f ? 1.f / gm : 0.f; if (lane == 0) SA[r] = gm * (1.f / 255.f);
#pragma unroll
        for (int j = 0; j < 16; ++j) { const float ratio = lm[j] * ginv; v4u o;
#pragma unroll
            for (int e = 0; e < 4; ++e) { const unsigned x = v[j][e] ^ 0x80808080u;
                o[e] = Q4_MAGIC((float)(x & 0xffu), (float)((x >> 8) & 0xffu), (float)((x >> 16) & 0xffu), (float)(x >> 24), ratio) ^ 0x80808080u; }
            *(GAS v4u*)(rowp + j * 1024) = o; }
    }
}
#define ROW_PREFETCH(xl_, xrow_) do { const char* g_ = (const char*)(xrow_) + lane * 16; \
        _Pragma("unroll") for (int j = 0; j < 16; ++j) __builtin_amdgcn_global_load_lds((const unsigned*)(g_ + j * 1024), (LAS unsigned*)((xl_) + j * 1024), 16, 0, 0); } while (0)
#define ROW_FROM_LDS(X, xl_) do { _Pragma("unroll") for (int j = 0; j < 16; ++j) X[j] = *(const LAS f32x4*)((xl_) + j * 1024 + lane * 16); LDS_WAIT(); } while (0)
__device__ __forceinline__ void p2_h(Frame& F) {
    CArgs* A = ARGS_PTR(); int tid_ = (int)threadIdx.x; asm volatile("" : "+v"(tid_)); const int lane_ = tid_ & 63;
    const int gw = F.vcu * NWAVES + F.wave, NGW = F.G * NWAVES, lane = lane_;
    const float* MODp = (const float*)(A->ws + WS_MOD); bf16* Hb = (bf16*)(A->ws + WS_H);
    LAS unsigned char* xl = F.lds + F.wave * 16384;
#define XROW(r_) ((r_) < MP ? (A->in[0]) + (size_t)(r_) * DM : (A->in[1]) + (size_t)((r_) - MP) * DM)
#define ROW_FROM_LDS8(X, xl_) do { _Pragma("unroll") for (int j = 0; j < 8; ++j) { X[2 * j] = *(const LAS f32x4*)((xl_) + j * 2048 + lane * 32); X[2 * j + 1] = *(const LAS f32x4*)((xl_) + j * 2048 + lane * 32 + 16); } LDS_WAIT(); } while (0)
    LAS unsigned char* vst = F.lds + 131072; int cur_vi = -1;
    int r = gw; if (r < MT) ROW_PREFETCH(xl, XROW(r));
#pragma unroll 1
    for (; r < MT; r += NGW) {
        f32x4 v[16];
        const int vi = r < MP ? 0 : 1 + ((r - MP) >> 12);
        if (vi != cur_vi) { __syncthreads();
#pragma unroll
            for (int i = 0; i < 4; ++i) { const int pc = tid_ + 512 * i, vv = pc >> 10, c = (pc & 1023) * 4; const float* s = vv == 0 ? (const float*)(A->ws + WS_FOLD) + vi * 16384 : MODp + vi * 24576;
                const f32x4 a = *(const GAS f32x4*)(s + c); *(LAS v2u*)(vst + vv * 8192 + c * 2) = (v2u){pkbf(a[0], a[1]), pkbf(a[2], a[3])}; }
            LDS_WAIT(); __syncthreads(); cur_vi = vi; }
        VM_WAIT(); ROW_FROM_LDS8(v, xl);
        const int rn = r + NGW; if (rn < MT) ROW_PREFETCH(xl, XROW(rn));
        float ss = 0.f;
#pragma unroll
        for (int j = 0; j < 16; ++j) ss += (v[j][0] * v[j][0] + v[j][1] * v[j][1]) + (v[j][2] * v[j][2] + v[j][3] * v[j][3]);
        const float rstd = 1.f / sqrtf(wave_sum(ss) * (1.f / DM) + RMS_EPS); bf16* hr = Hb + (size_t)r * DM + 8 * lane; float hm = 0.f;
#pragma unroll
        for (int j = 0; j < 8; ++j) { const v4u gq = *(const LAS v4u*)(vst + (512 * j + 8 * lane) * 2), sq = *(const LAS v4u*)(vst + 8192 + (512 * j + 8 * lane) * 2);
#pragma unroll
            for (int hh = 0; hh < 2; ++hh) { const int k = 2 * j + hh;
                const f32x4 gs = (f32x4){bflo(gq[2 * hh]), bfhi(gq[2 * hh]), bflo(gq[2 * hh + 1]), bfhi(gq[2 * hh + 1])}, sh = (f32x4){bflo(sq[2 * hh]), bfhi(sq[2 * hh]), bflo(sq[2 * hh + 1]), bfhi(sq[2 * hh + 1])};
                v[k] = (v[k] * rstd) * gs + sh;
                hm = fmaxf(hm, fmaxf(fmaxf(fabsf(v[k][0]), fabsf(v[k][1])), fmaxf(fabsf(v[k][2]), fabsf(v[k][3])))); }
            *(GAS v4u*)(hr + 512 * j) = (v4u){pkbf(v[2 * j][0], v[2 * j][1]), pkbf(v[2 * j][2], v[2 * j][3]), pkbf(v[2 * j + 1][0], v[2 * j + 1][1]), pkbf(v[2 * j + 1][2], v[2 * j + 1][3])}; }
#pragma unroll
        for (int o = 1; o < 64; o <<= 1) hm = fmaxf(hm, __shfl_xor(hm, o));
        const float hinv = hm > 0.f ? 127.f / hm : 0.f; if (lane == 0) ((float*)(A->ws + WS_SAHI))[r] = hm * (1.f / 127.f);
        unsigned char* hq = (unsigned char*)(A->ws + WS_HQ) + (size_t)r * DM + 8 * lane;
#pragma unroll
        for (int j = 0; j < 8; ++j) { unsigned w2[2];
#pragma unroll
            for (int hh = 0; hh < 2; ++hh) { const int k = 2 * j + hh; w2[hh] = Q4_MAGIC(v[k][0], v[k][1], v[k][2], v[k][3], hinv); }
            *(GAS v2u*)(hq + 512 * j) = (v2u){w2[0], w2[1]}; }
    }
}
__device__ __forceinline__ void p4_rope_conv(Frame& F) {
    CArgs* A = ARGS_PTR(); int tid_ = (int)threadIdx.x; asm volatile("" : "+v"(tid_)); const int lane_ = tid_ & 63;
    const int gw = F.vcu * NWAVES + F.wave, NGW = F.G * NWAVES, lane = lane_;
    const int gt = F.vcu * 512 + tid_, NT = F.G * 512;
    {   const int u = lane >> 1, hh = u >> 1, a = u & 1, m = lane & 1;
        const float* TAB = (const float*)(A->ws + WS_ROPE);
#define ROPE_ROW(it_) ({ const int sr_ = (it_), b_ = sr_ >> 12, t_ = sr_ & 4095; \
            ((bf16*)(A->ws + WS_KS)) + ((size_t)b_ * KVS + 512 + t_) * 2048 + hh * 128 + a * 64 + 16 * m; })
        v4u xn[4];
        if (gw < MS) { const GAS v4u* q1 = (const GAS v4u*)ROPE_ROW(gw); xn[0] = q1[0]; xn[1] = q1[1]; xn[2] = q1[4]; xn[3] = q1[5]; }
#pragma unroll 1
        for (int it = gw; it < MS; it += NGW) {
            const int t = it & 4095;
            const int pos = a ? (t & 63) : (t >> 6);
            GAS v4u* p1 = (GAS v4u*)ROPE_ROW(it); GAS v4u* p2 = p1 + 4;
            const GAS f32x4* tp = (const GAS f32x4*)(TAB + (pos * 32 + 16 * m) * 2);
            f32x4 csv[8];
#pragma unroll
            for (int e = 0; e < 8; ++e) csv[e] = tp[e];
            const v4u x1a = xn[0], x1b = xn[1], x2a = xn[2], x2b = xn[3];
            asm volatile("" ::: "memory");
            {   const int nx = it + NGW < MS ? it + NGW : MS - 1; const GAS v4u* q1 = (const GAS v4u*)ROPE_ROW(nx); xn[0] = q1[0]; xn[1] = q1[1]; xn[2] = q1[4]; xn[3] = q1[5]; }
            asm volatile("" ::: "memory");
            v4u o1a, o1b, o2a, o2b;
#define ROPE4(X1, X2, O1, O2, k0_) do { _Pragma("unroll") for (int e = 0; e < 4; ++e) { const f32x4 cs = csv[(k0_) + e]; \
                const float u1 = bflo(X1[e]), v1 = bfhi(X1[e]), u2 = bflo(X2[e]), v2 = bfhi(X2[e]); \
                O1[e] = pkbf(u1 * cs[0] - u2 * cs[1], v1 * cs[2] - v2 * cs[3]); O2[e] = pkbf(u1 * cs[1] + u2 * cs[0], v1 * cs[3] + v2 * cs[2]); } } while (0)
            ROPE4(x1a, x2a, o1a, o2a, 0); ROPE4(x1b, x2b, o1b, o2b, 4);
#undef ROPE4
            p1[0] = o1a; p1[1] = o1b; p2[0] = o2a; p2[1] = o2b;
        }
#undef ROPE_ROW
    }
    for (int it = gw; it < 1536 * 6; it += NGW) {
        const int tb = it / 6, cg = it - tb * 6, t0 = tb * 16, c0 = cg * 512 + lane * 8;
        int seq_lo, seq_hi; if (t0 < MP) { seq_lo = t0 & ~255; seq_hi = seq_lo + 256; } else { seq_lo = MP + ((t0 - MP) & ~4095); seq_hi = seq_lo + 4096; }
        v4u raw[20];
        const bf16* xin = ((const bf16*)(A->ws + WS_XR)) + c0;
#pragma unroll
        for (int i = 0; i < 20; ++i) { const int t = t0 - 2 + i; raw[i] = (v4u){0u, 0u, 0u, 0u}; if (t >= seq_lo && t < seq_hi) raw[i] = *(const GAS v4u*)(xin + (size_t)t * 3072); }
        float w[5][8], bias[8];
#pragma unroll
        for (int j = 0; j < 5; ++j) { const f32x4 a0 = *(const GAS f32x4*)((A->in[20]) + j * 3072 + c0), a1 = *(const GAS f32x4*)((A->in[20]) + j * 3072 + c0 + 4);
#pragma unroll
            for (int e = 0; e < 4; ++e) { w[j][e] = a0[e]; w[j][4 + e] = a1[e]; } }
        { const f32x4 a0 = *(const GAS f32x4*)((A->in[21]) + c0), a1 = *(const GAS f32x4*)((A->in[21]) + c0 + 4);
#pragma unroll
          for (int e = 0; e < 4; ++e) { bias[e] = a0[e]; bias[4 + e] = a1[e]; } }
        bf16* xout = ((bf16*)(A->ws + WS_XC)) + (size_t)t0 * 3072 + c0;
#pragma unroll
        for (int i = 0; i < 16; ++i) { float o[8];
#pragma unroll
            for (int e2 = 0; e2 < 4; ++e2) { float s0 = bias[2 * e2], s1 = bias[2 * e2 + 1];
#pragma unroll
                for (int j = 0; j < 5; ++j) { const unsigned r = raw[i + j][e2]; s0 += w[j][2 * e2] * bflo(r); s1 += w[j][2 * e2 + 1] * bfhi(r); }
                o[2 * e2] = silu_f(s0); o[2 * e2 + 1] = silu_f(s1); }
            *(GAS v4u*)(xout + (size_t)i * 3072) = (v4u){pkbf(o[0], o[1]), pkbf(o[2], o[3]), pkbf(o[4], o[5]), pkbf(o[6], o[7])}; }
    }
    for (int i = gt; i < MT * 64; i += NT) { const float x = ((float*)(A->ws + WS_DT))[i] + (A->in[23])[i & 63]; ((float*)(A->ws + WS_DT))[i] = fmaxf(x, 0.f) + log1pf(__expf(-fabsf(x))); }
}

__device__ __forceinline__ void chunk_scan(float a0, float a1, int lane, float& P0, float& P1, float& T) {
    P0 = wave_incl_scan(a0, lane); const float t0 = __shfl(P0, 63); P1 = wave_incl_scan(a1, lane) + t0; T = __shfl(P1, 63);
}

__device__ __forceinline__ void p5_states(Frame& F) {
    CArgs* A = ARGS_PTR(); int tid_ = (int)threadIdx.x; asm volatile("" : "+v"(tid_)); const int lane_ = tid_ & 63;
    LAS bf16* Bt = (LAS bf16*)(F.lds);
    LAS unsigned char* wbase = F.lds + 34816 + F.wave * 9728;
    LAS bf16* xw = (LAS bf16*)wbase;
    LAS float* wf = (LAS float*)(wbase + 8704); LAS float* wb = wf + 128;
    const int lane = lane_, q = lane >> 4, c = lane & 15;
    bf16* ST = (bf16*)(A->out + O_YS);
#pragma unroll 1
    for (int un = F.vcu; un < 192 * 4; un += F.G) {
        const int cs = un >> 2, g = un & 3, row0 = cs * 128, h = g * 8 + F.wave;
        v4u tbv_[4];
#pragma unroll
        for (int k = 0; k < 4; ++k) { const int i = tid_ + 512 * k, s = i >> 4, n8 = (i & 15) * 8; tbv_[k] = *(const GAS v4u*)(((bf16*)(A->ws + WS_XC)) + (size_t)(row0 + s) * 3072 + 2048 + g * 128 + n8); }
#pragma unroll
        for (int k = 0; k < 4; ++k) { const int i = tid_ + 512 * k, s = i >> 4, n8 = (i & 15) * 8;
            const v4u v = tbv_[k];
            Bt[(n8 + 0) * 136 + s] = (bf16)(v.x & 0xffffu); Bt[(n8 + 1) * 136 + s] = (bf16)(v.x >> 16); Bt[(n8 + 2) * 136 + s] = (bf16)(v.y & 0xffffu); Bt[(n8 + 3) * 136 + s] = (bf16)(v.y >> 16);
            Bt[(n8 + 4) * 136 + s] = (bf16)(v.z & 0xffffu); Bt[(n8 + 5) * 136 + s] = (bf16)(v.z >> 16); Bt[(n8 + 6) * 136 + s] = (bf16)(v.w & 0xffffu); Bt[(n8 + 7) * 136 + s] = (bf16)(v.w >> 16); }
        {
            const float dtf0 = ((float*)(A->ws + WS_DT))[(size_t)(row0 + lane) * 64 + h], dtf1 = ((float*)(A->ws + WS_DT))[(size_t)(row0 + 64 + lane) * 64 + h];
            const float dtb0 = ((float*)(A->ws + WS_DT))[(size_t)(row0 + lane) * 64 + 32 + h], dtb1 = ((float*)(A->ws + WS_DT))[(size_t)(row0 + 64 + lane) * 64 + 32 + h];
            const float Af = -__expf((A->in[22])[h]), Ab = -__expf((A->in[22])[32 + h]);
            float P0, P1, T; chunk_scan(dtf0 * Af, dtf1 * Af, lane, P0, P1, T);
            wf[lane] = __expf(T - P0) * dtf0; wf[64 + lane] = __expf(T - P1) * dtf1;
            float Q0, Q1, Tb; chunk_scan(dtb0 * Ab, dtb1 * Ab, lane, Q0, Q1, Tb);
            wb[lane] = __expf(Q0 - dtb0 * Ab) * dtb0; wb[64 + lane] = __expf(Q1 - dtb1 * Ab) * dtb1;
            if (lane == 0) { ((float*)(A->ws + WS_DEC))[(cs * 2 + 0) * 32 + h] = __expf(T); ((float*)(A->ws + WS_DEC))[(cs * 2 + 1) * 32 + h] = __expf(Tb); }
        }
        __syncthreads();
#pragma unroll 1
        for (int ph = 0; ph < 2; ++ph) {
#pragma unroll
            for (int i = 0; i < 8; ++i) { const int s = i * 16 + (lane >> 2), pc = (lane & 3) * 8;
                const v4u v = *(const GAS v4u*)(((bf16*)(A->ws + WS_XC)) + (size_t)(row0 + s) * 3072 + h * 64 + ph * 32 + pc);
                LAS unsigned* d = (LAS unsigned*)(xw + s * 34 + pc); d[0] = v.x; d[1] = v.y; d[2] = v.z; d[3] = v.w; }
            LDS_WAIT();
#pragma unroll 1
            for (int d = 0; d < 2; ++d) {
                f32x4 acc[2][8];
#pragma unroll
                for (int mt = 0; mt < 2; ++mt)
#pragma unroll
                    for (int nt = 0; nt < 8; ++nt) acc[mt][nt] = (f32x4){0.f, 0.f, 0.f, 0.f};
                const LAS float* wd = d ? wb : wf;
#pragma unroll 1
                for (int ks = 0; ks < 4; ++ks) {
                    const int sb = ks * 32 + q * 8;
                    bf16x8 bfr[8];
#pragma unroll
                    for (int nt = 0; nt < 8; ++nt) bfr[nt] = *(const LAS bf16x8*)(Bt + (nt * 16 + c) * 136 + sb);
                    const f32x4 w0 = *(const LAS f32x4*)(wd + sb), w1 = *(const LAS f32x4*)(wd + sb + 4);
#pragma unroll
                    for (int mt = 0; mt < 2; ++mt) {
                        float xv[8];
#pragma unroll
                        for (int j = 0; j < 8; ++j) xv[j] = __uint_as_float(((unsigned)xw[(sb + j) * 34 + mt * 16 + c]) << 16);
                        v4u au; au.x = pkbf(xv[0] * w0[0], xv[1] * w0[1]); au.y = pkbf(xv[2] * w0[2], xv[3] * w0[3]);
                        au.z = pkbf(xv[4] * w1[0], xv[5] * w1[1]); au.w = pkbf(xv[6] * w1[2], xv[7] * w1[3]);
                        const bf16x8 afr = __builtin_bit_cast(bf16x8, au);
#pragma unroll
                        for (int nt = 0; nt < 8; ++nt) acc[mt][nt] = __builtin_amdgcn_mfma_f32_16x16x32_bf16(bfr[nt], afr, acc[mt][nt], 0, 0, 0);
                    }
                }
#pragma unroll
                for (int mt = 0; mt < 2; ++mt) { const int pp = ph * 32 + mt * 16 + c;
                    bf16* dst = ST + ((((size_t)cs * 2 + d) * 32 + h) * 64 + pp) * 128 + 4 * q;
#pragma unroll
                    for (int nt = 0; nt < 8; ++nt) *(GAS v2u*)(dst + nt * 16) = (v2u){pkbf(acc[mt][nt][0], acc[mt][nt][1]), pkbf(acc[mt][nt][2], acc[mt][nt][3])}; }
            }
        }
        __syncthreads();
    }
}
template <int NC, bool SAMP> __device__ __forceinline__ void p6_item(CArgs* A, int j) {
    const int n8 = (j & 15) * 8, p = (j >> 4) & 63, h = (j >> 10) & 31, dir = (j >> 15) & 1, b = j >> 16;
    const int cs0 = SAMP ? 64 + b * 32 : b * 2;
    bf16* ST = (bf16*)(A->out + O_YS); const float* DEC = (const float*)(A->ws + WS_DEC);
    v4u sv[NC]; float dec[NC]; float carry[8];
#pragma unroll
    for (int ci = 0; ci < NC; ++ci) { const int cs = cs0 + (dir ? NC - 1 - ci : ci);
        sv[ci] = *(const GAS v4u*)(ST + ((((size_t)cs * 2 + dir) * 32 + h) * 64 + p) * 128 + n8); dec[ci] = DEC[(cs * 2 + dir) * 32 + h]; }
    if (SAMP) { const float* init = (dir ? (A->in[6]) : (A->in[5])) + (((size_t)b * 32 + h) * 64 + p) * 128 + n8; const f32x4 a = *(const GAS f32x4*)init, bb = *(const GAS f32x4*)(init + 4);
#pragma unroll
        for (int e = 0; e < 4; ++e) { carry[e] = a[e]; carry[4 + e] = bb[e]; } }
    else {
#pragma unroll
        for (int e = 0; e < 8; ++e) carry[e] = 0.f; }
#pragma unroll
    for (int ci = 0; ci < NC; ++ci) { const int cs = cs0 + (dir ? NC - 1 - ci : ci);
        *(GAS v4u*)(ST + ((((size_t)cs * 2 + dir) * 32 + h) * 64 + p) * 128 + n8) = (v4u){pkbf(carry[0], carry[1]), pkbf(carry[2], carry[3]), pkbf(carry[4], carry[5]), pkbf(carry[6], carry[7])};
        const float d = dec[ci]; const v4u s = sv[ci];
        carry[0] = carry[0] * d + bflo(s.x); carry[1] = carry[1] * d + bfhi(s.x); carry[2] = carry[2] * d + bflo(s.y); carry[3] = carry[3] * d + bfhi(s.y);
        carry[4] = carry[4] * d + bflo(s.z); carry[5] = carry[5] * d + bfhi(s.z); carry[6] = carry[6] * d + bflo(s.w); carry[7] = carry[7] * d + bfhi(s.w); }
    if (!SAMP) { float* o = A->out + (dir ? O_SB : O_SF) + (((size_t)b * 32 + h) * 64 + p) * 128 + n8;
        *(GAS f32x4*)o = (f32x4){carry[0], carry[1], carry[2], carry[3]}; *(GAS f32x4*)(o + 4) = (f32x4){carry[4], carry[5], carry[6], carry[7]}; }
}
__device__ __forceinline__ void p6_scan(Frame& F) {
    CArgs* A = ARGS_PTR(); int tid_ = (int)threadIdx.x; asm volatile("" : "+v"(tid_));
    const int gt = F.vcu * 512 + tid_, NT = F.G * 512;
    constexpr int NS = 4 * 2 * 32 * 64 * 16, NP = 32 * 2 * 32 * 64 * 16;
#pragma unroll 1
    for (int idx = gt; idx < NS; idx += NT) p6_item<32, true>(A, idx);
#pragma unroll 1
    for (int idx = gt; idx < NP; idx += NT) p6_item<2, false>(A, idx);
}
__device__ __forceinline__ void p7_attention(Frame& F, char* lds_generic) {
    CArgs* A = ARGS_PTR(); int tid_ = (int)threadIdx.x; asm volatile("" : "+v"(tid_)); const int lane_ = tid_ & 63;
    float lam;
    {   const int l = lane_; const float d1 = (A->in[15])[l] * (A->in[16])[l] + (A->in[15])[64 + l] * (A->in[16])[64 + l], d2 = (A->in[17])[l] * (A->in[18])[l] + (A->in[17])[64 + l] * (A->in[18])[64 + l];
        lam = expf(wave_sum(d1)) - expf(wave_sum(d2)) + 0.2f; }
    float* scr = ((float*)(A->ws + WS_ASCR)) + (size_t)blockIdx.x * (128 * 512); bf16* CATb = (bf16*)(A->ws + WS_CAT); const float* gsub = A->in[19];
    constexpr int NU_S = 4 * 8 * 16, NU_P = 32 * 8;
#pragma unroll 1
    for (int un = F.vcu; un < NU_S + NU_P; un += F.G) {
        int qrow0, krow0, seq, h, t0 = 0; const bf16 *Kb, *Vb; const float* rtab = nullptr;
        if (un < NU_S) { const int qb = un & 15; h = (un >> 4) & 7; const int b = un >> 7; qrow0 = MP + b * 4096 + qb * 256; krow0 = b * KVS; seq = KVS; Kb = ((bf16*)(A->ws + WS_KS)); Vb = ((bf16*)(A->ws + WS_VS)); t0 = qb * 256; rtab = (const float*)(A->ws + WS_ROPE); }
        else { const int u2 = un - NU_S; h = u2 & 7; const int b = u2 >> 3; qrow0 = b * 256; krow0 = b * 256; seq = 256; Kb = ((bf16*)(A->ws + WS_KP)); Vb = ((bf16*)(A->ws + WS_VP)); }
        const bf16* Qp = ((bf16*)(A->ws + WS_Q)) + (size_t)qrow0 * 2048 + h * 256; const bf16* Kp = Kb + (size_t)krow0 * 2048 + h * 256; const bf16* Vp = Vb + (size_t)krow0 * 2048 + h * 256;
#pragma unroll 1
        for (int pp = 0; pp < (PROBE_DUP == 7 ? 4 : 2); ++pp) { const int pass = pp & 1;
            att2::attn_pass(pass, Qp + pass * 128, Kp + pass * 128, Vp, scr, CATb + (size_t)qrow0 * DM + h * 256, gsub, lam, seq, lds_generic, rtab, t0);
        }
    }
    asm volatile("s_waitcnt vmcnt(0) lgkmcnt(0)" ::: "memory"); __syncthreads();
}
typedef short s16x4 __attribute__((ext_vector_type(4)));
template <int OFF> __device__ __forceinline__ s16x4 p8_tr_read(int vb) { s16x4 r; asm volatile("ds_read_b64_tr_b16 %0, %1 offset:%2" : "=&v"(r) : "v"(vb), "i"(OFF) : "memory"); return r; }
constexpr int P8_CS = 0, P8_HA = 34816, P8_BUF = 51200, P8_BUFSZ = 55296, P8_PB = 17408, P8_XT = 34816, P8_XS = 80;
__device__ __forceinline__ void p8_ssd_out(Frame& F) {
    CArgs* A = ARGS_PTR(); int tid_ = (int)threadIdx.x; asm volatile("" : "+v"(tid_)); const int lane_ = tid_ & 63;
    LAS bf16* Cs = (LAS bf16*)(F.lds + P8_CS);
    LAS bf16* Bs = (LAS bf16*)(F.lds + P8_BUF + P8_BUFSZ);
    LAS float* HA = (LAS float*)(F.lds + P8_HA);
    const int lane = lane_, q = lane >> 4, c = lane & 15, w = F.wave;
    const bf16* XC = (const bf16*)(A->ws + WS_XC); const float* DT = (const float*)(A->ws + WS_DT); const bf16* ST = (const bf16*)(A->out + O_YS);
    const bf16* Zb = (const bf16*)(A->ws + WS_Z); bf16* CAT = (bf16*)(A->ws + WS_CAT);
    const int pr0 = tid_ >> 4, pn8 = (tid_ & 15) * 8;
    const int xs0 = tid_ >> 3, xp8 = (tid_ & 7) * 8;
#pragma unroll 1
    for (int un = F.vcu; un < 192 * 4; un += F.G) {
        const int cs = un >> 2, g = un & 3, row0 = cs * 128;
        v4u rpf[2], rpb[2], rx[2];
#define P8_LOADH(hl_) do { const int h_ = 8 * g + (hl_); const bf16* pf_ = ST + ((((size_t)cs * 2 + 0) * 32 + h_) * 64) * 128; const bf16* pb_ = pf_ + (size_t)32 * 64 * 128; \
            rpf[0] = *(const GAS v4u*)(pf_ + pr0 * 128 + pn8); rpf[1] = *(const GAS v4u*)(pf_ + (pr0 + 32) * 128 + pn8); \
            rpb[0] = *(const GAS v4u*)(pb_ + pr0 * 128 + pn8); rpb[1] = *(const GAS v4u*)(pb_ + (pr0 + 32) * 128 + pn8); \
            rx[0] = *(const GAS v4u*)(XC + (size_t)(row0 + xs0) * 3072 + h_ * 64 + xp8); rx[1] = *(const GAS v4u*)(XC + (size_t)(row0 + xs0 + 64) * 3072 + h_ * 64 + xp8); } while (0)
#define P8_STOREH(boff_) do { LAS unsigned char* b_ = F.lds + (boff_); \
            *(LAS v4u*)(b_ + (pr0 * 136 + pn8) * 2) = rpf[0]; *(LAS v4u*)(b_ + ((pr0 + 32) * 136 + pn8) * 2) = rpf[1]; \
            *(LAS v4u*)(b_ + P8_PB + (pr0 * 136 + pn8) * 2) = rpb[0]; *(LAS v4u*)(b_ + P8_PB + ((pr0 + 32) * 136 + pn8) * 2) = rpb[1]; \
            *(LAS v4u*)(b_ + P8_XT + (xs0 * P8_XS + xp8) * 2) = rx[0]; *(LAS v4u*)(b_ + P8_XT + ((xs0 + 64) * P8_XS + xp8) * 2) = rx[1]; } while (0)
        P8_LOADH(0);
        {   v4u tb_[4], tc_[4];
#pragma unroll
            for (int k = 0; k < 4; ++k) { const int i = tid_ + 512 * k, s = i >> 4, n8 = (i & 15) * 8; const bf16* src = XC + (size_t)(row0 + s) * 3072 + 2048 + g * 128 + n8;
                tb_[k] = *(const GAS v4u*)src; tc_[k] = *(const GAS v4u*)(src + 512); }
#pragma unroll
            for (int k = 0; k < 4; ++k) { const int i = tid_ + 512 * k, s = i >> 4, n8 = (i & 15) * 8; *(LAS v4u*)(Bs + s * 136 + n8) = tb_[k]; *(LAS v4u*)(Cs + s * 136 + n8) = tc_[k]; } }
        {   const int h = g * 8 + w; LAS float* ha = HA + w * 512; const float* al = A->in[22];
            const float dtf0 = DT[(size_t)(row0 + lane) * 64 + h], dtf1 = DT[(size_t)(row0 + 64 + lane) * 64 + h];
            const float dtb0 = DT[(size_t)(row0 + lane) * 64 + 32 + h], dtb1 = DT[(size_t)(row0 + 64 + lane) * 64 + 32 + h];
            const float Af = -__expf(al[h]), Ab = -__expf(al[32 + h]);
            float P0, P1, T; chunk_scan(dtf0 * Af, dtf1 * Af, lane, P0, P1, T);
            ha[lane] = P0; ha[64 + lane] = P1; ha[128 + lane] = dtf0; ha[192 + lane] = dtf1;
            float Q0, Q1, Tb; chunk_scan(dtb0 * Ab, dtb1 * Ab, lane, Q0, Q1, Tb);
            ha[256 + lane] = Tb - Q0 + dtb0 * Ab; ha[320 + lane] = Tb - Q1 + dtb1 * Ab; ha[384 + lane] = dtb0; ha[448 + lane] = dtb1; }
        P8_STOREH(P8_BUF);
        __syncthreads();
        f32x4 cbT[8];
#pragma unroll
        for (int st = 0; st < 8; ++st) cbT[st] = (f32x4){0.f, 0.f, 0.f, 0.f};
#pragma unroll
        for (int ks = 0; ks < 4; ++ks) { const bf16x8 cf = *(const LAS bf16x8*)(Cs + (16 * w + c) * 136 + ks * 32 + q * 8);
#pragma unroll
            for (int st = 0; st < 8; ++st) { const bf16x8 bf = *(const LAS bf16x8*)(Bs + (16 * st + c) * 136 + ks * 32 + q * 8);
                cbT[st] = __builtin_amdgcn_mfma_f32_16x16x32_bf16(bf, cf, cbT[st], 0, 0, 0); } }
        __syncthreads();
        const int l = 16 * w + c;
        float ssq = 0.f;
        bf16* orow = CAT + (size_t)(row0 + l) * DM + 2048 + g * 512;
#pragma unroll 1
        for (int hl = 0; hl < 8; ++hl) {
            const int h = 8 * g + hl, boff = P8_BUF + (hl & 1) * P8_BUFSZ;
            if (hl < 7) P8_LOADH(hl + 1);
            v2u zv[4];
#pragma unroll
            for (int pt = 0; pt < 4; ++pt) zv[pt] = *(const GAS v2u*)(Zb + (size_t)(row0 + l) * 2048 + h * 64 + 16 * pt + 4 * q);
            const LAS float* ha = HA + hl * 512; const LAS bf16* pfl = (const LAS bf16*)(F.lds + boff); const LAS bf16* pbl = (const LAS bf16*)(F.lds + boff + P8_PB); const LAS bf16* xt = (const LAS bf16*)(F.lds + boff + P8_XT);
            const float csf_l = ha[l], csb_l = ha[256 + l];
            f32x4 accD[4], accF[4], accB[4];
#pragma unroll
            for (int pt = 0; pt < 4; ++pt) { accD[pt] = (f32x4){0.f, 0.f, 0.f, 0.f}; accF[pt] = accD[pt]; accB[pt] = accD[pt]; }
            bf16x8 wfr[4];
            {
                f32x4 csv[8], dtv[8];
#pragma unroll
                for (int st = 0; st < 8; ++st) { const LAS float* tb = ha + ((st < w) ? 0 : 256) + 16 * st + 4 * q; csv[st] = *(const LAS f32x4*)tb; dtv[st] = *(const LAS f32x4*)(tb + 128); }
#pragma unroll
                for (int u = 0; u < 4; ++u) {
                    float wv[8];
#pragma unroll
                    for (int half = 0; half < 2; ++half) { const int st = 2 * u + half, s4 = 16 * st + 4 * q; const float cl = (st < w) ? csf_l : csb_l;
#pragma unroll
                        for (int r = 0; r < 4; ++r) wv[half * 4 + r] = cbT[st][r] * (__expf(cl - csv[st][r]) * dtv[st][r]);
                        if (st == w) { const f32x4 csf_s = *(const LAS f32x4*)(ha + s4), dtf_s = *(const LAS f32x4*)(ha + 128 + s4), csb_s = *(const LAS f32x4*)(ha + 256 + s4), dtb_s = *(const LAS f32x4*)(ha + 384 + s4);
#pragma unroll
                            for (int r = 0; r < 4; ++r) { const int s = s4 + r; const bool fw = s <= l;
                                const float e = __expf(fminf(fw ? csf_l - csf_s[r] : csb_l - csb_s[r], 0.f));
                                const float f = e * (fw ? dtf_s[r] : dtb_s[r]) + (s == l ? dtb_s[r] : 0.f);
                                wv[half * 4 + r] = cbT[st][r] * f; } }
                    }
                    v4u wu; wu.x = pkbf(wv[0], wv[1]); wu.y = pkbf(wv[2], wv[3]); wu.z = pkbf(wv[4], wv[5]); wu.w = pkbf(wv[6], wv[7]);
                    wfr[u] = __builtin_bit_cast(bf16x8, wu);
                }
            }
            {   const int vb = (int)(unsigned)(size_t)xt + (((4 * q + (c >> 2)) * P8_XS + 4 * (c & 3)) * 2);
#define P8_TR(u_, t_, pt_) p8_tr_read<((32 * (u_) + 16 * (t_)) * P8_XS + 16 * (pt_)) * 2>(vb)
#define P8_KSTEP(u_) do { const s16x4 a0 = P8_TR(u_, 0, 0), b0 = P8_TR(u_, 1, 0), a1 = P8_TR(u_, 0, 1), b1 = P8_TR(u_, 1, 1), a2 = P8_TR(u_, 0, 2), b2 = P8_TR(u_, 1, 2), a3 = P8_TR(u_, 0, 3), b3 = P8_TR(u_, 1, 3); \
                    asm volatile("s_waitcnt lgkmcnt(0)" ::: "memory"); __builtin_amdgcn_sched_barrier(0); \
                    accD[0] = __builtin_amdgcn_mfma_f32_16x16x32_bf16((bf16x8){a0[0], a0[1], a0[2], a0[3], b0[0], b0[1], b0[2], b0[3]}, wfr[u_], accD[0], 0, 0, 0); \
                    accD[1] = __builtin_amdgcn_mfma_f32_16x16x32_bf16((bf16x8){a1[0], a1[1], a1[2], a1[3], b1[0], b1[1], b1[2], b1[3]}, wfr[u_], accD[1], 0, 0, 0); \
                    accD[2] = __builtin_amdgcn_mfma_f32_16x16x32_bf16((bf16x8){a2[0], a2[1], a2[2], a2[3], b2[0], b2[1], b2[2], b2[3]}, wfr[u_], accD[2], 0, 0, 0); \
                    accD[3] = __builtin_amdgcn_mfma_f32_16x16x32_bf16((bf16x8){a3[0], a3[1], a3[2], a3[3], b3[0], b3[1], b3[2], b3[3]}, wfr[u_], accD[3], 0, 0, 0); } while (0)
                P8_KSTEP(0); P8_KSTEP(1); P8_KSTEP(2); P8_KSTEP(3);
#undef P8_KSTEP
#undef P8_TR
            }
#pragma unroll
            for (int ks = 0; ks < 4; ++ks) { const bf16x8 cf = *(const LAS bf16x8*)(Cs + (16 * w + c) * 136 + ks * 32 + q * 8);
#pragma unroll
                for (int pt = 0; pt < 4; ++pt) { const bf16x8 a = *(const LAS bf16x8*)(pfl + (16 * pt + c) * 136 + ks * 32 + q * 8), b = *(const LAS bf16x8*)(pbl + (16 * pt + c) * 136 + ks * 32 + q * 8);
                    accF[pt] = __builtin_amdgcn_mfma_f32_16x16x32_bf16(a, cf, accF[pt], 0, 0, 0); accB[pt] = __builtin_amdgcn_mfma_f32_16x16x32_bf16(b, cf, accB[pt], 0, 0, 0); } }
            const float ef = __expf(csf_l), eb = __expf(csb_l), dsk = (A->in[24])[h];
#pragma unroll
            for (int pt = 0; pt < 4; ++pt) { const int p0 = 16 * pt + 4 * q;
                const v2u xv = *(const LAS v2u*)(xt + l * P8_XS + p0);
                const float xs4[4] = {bflo(xv.x), bfhi(xv.x), bflo(xv.y), bfhi(xv.y)}, zs4[4] = {bflo(zv[pt].x), bfhi(zv[pt].x), bflo(zv[pt].y), bfhi(zv[pt].y)};
                float y[4];
#pragma unroll
                for (int r = 0; r < 4; ++r) { y[r] = (accD[pt][r] + ef * accF[pt][r] + eb * accB[pt][r] + dsk * xs4[r]) * (zs4[r] * __builtin_amdgcn_rcpf(1.f + __expf(-zs4[r]))); ssq += y[r] * y[r]; }
                *(GAS v2u*)(orow + hl * 64 + p0) = (v2u){pkbf(y[0], y[1]), pkbf(y[2], y[3])}; }
            if (hl < 7) P8_STOREH(P8_BUF + ((hl & 1) ^ 1) * P8_BUFSZ);
            __syncthreads();
        }
#undef P8_LOADH
#undef P8_STOREH
        ssq += __shfl_xor(ssq, 16); ssq += __shfl_xor(ssq, 32);
        const float rstd = 1.f / sqrtf(ssq * (1.f / 512.f) + RMS_EPS);
        if (q == 0) ((float*)(A->ws + WS_RST))[(size_t)(row0 + l) * 4 + g] = rstd;
    }
}
__device__ __forceinline__ void p9a_quant_cat(Frame& F) {
    CArgs* A = ARGS_PTR(); int tid_ = (int)threadIdx.x; asm volatile("" : "+v"(tid_)); const int lane = tid_ & 63;
    const int gw = F.vcu * NWAVES + F.wave, NGW = F.G * NWAVES;
    const bf16* CATb = (const bf16*)(A->ws + WS_CAT); unsigned char* CQ = (unsigned char*)(A->ws + WS_CATQ); float* SAC = (float*)(A->ws + WS_SAC);
    const float sg1 = (lane & 1) ? -1.f : 1.f, sg2 = (lane & 2) ? -1.f : 1.f, sg4 = (lane & 4) ? -1.f : 1.f;
    v4u vn[8];
    if (gw < MT) { const bf16* src = CATb + (size_t)gw * DM + 8 * lane;
#pragma unroll
        for (int j = 0; j < 8; ++j) vn[j] = *(const GAS v4u*)(src + j * 512); }
#pragma unroll 1
    for (int r = gw; r < MT; r += NGW) {
        unsigned char* dst = CQ + (size_t)r * DM + 8 * lane;
        v4u v[8]; float mx = 0.f;
#pragma unroll
        for (int j = 0; j < 8; ++j) v[j] = vn[j];
        const f32x4 rst = *(const GAS f32x4*)((const float*)(A->ws + WS_RST) + (size_t)r * 4);
        f32x4 gnv[4][2];
#pragma unroll
        for (int j = 0; j < 4; ++j) { const float* gn = (A->in[25]) + j * 512 + 8 * lane; gnv[j][0] = *(const GAS f32x4*)gn; gnv[j][1] = *(const GAS f32x4*)(gn + 4); }
        asm volatile("" ::: "memory");
        {   const int rn = r + NGW < MT ? r + NGW : MT - 1; const bf16* src = CATb + (size_t)rn * DM + 8 * lane;
#pragma unroll
            for (int j = 0; j < 8; ++j) vn[j] = *(const GAS v4u*)(src + j * 512); }
        float x[8][8];
#pragma unroll
        for (int j = 0; j < 8; ++j) {
#pragma unroll
            for (int e = 0; e < 4; ++e) { x[j][2 * e] = bflo(v[j][e]); x[j][2 * e + 1] = bfhi(v[j][e]); }
            if (j >= 4) { const f32x4 g0 = gnv[j - 4][0], g1 = gnv[j - 4][1]; const float rs = rst[j - 4];
#pragma unroll
                for (int e = 0; e < 4; ++e) { x[j][e] *= rs * g0[e]; x[j][4 + e] *= rs * g1[e]; } }
#pragma unroll
            for (int s = 1; s < 8; s <<= 1)
#pragma unroll
                for (int i = 0; i < 8; ++i) if (!(i & s)) { const float a = x[j][i], b = x[j][i | s]; x[j][i] = a + b; x[j][i | s] = a - b; }
#pragma unroll
            for (int i = 0; i < 8; ++i) {
                int iv = __builtin_bit_cast(int, x[j][i]);
                float v1 = fmaf(x[j][i], sg1, __builtin_bit_cast(float, __builtin_amdgcn_update_dpp(0, iv, 0xB1, 0xf, 0xf, true)));
                iv = __builtin_bit_cast(int, v1);
                float v2 = fmaf(v1, sg2, __builtin_bit_cast(float, __builtin_amdgcn_update_dpp(0, iv, 0x4E, 0xf, 0xf, true)));
                iv = __builtin_bit_cast(int, v2);
                int pr = __builtin_amdgcn_update_dpp(iv, iv, 0x104, 0xf, 0x5, false);
                pr = __builtin_amdgcn_update_dpp(pr, iv, 0x114, 0xf, 0xA, false);
                x[j][i] = fmaf(v2, sg4, __builtin_bit_cast(float, pr)); }
#pragma unroll
            for (int i = 0; i < 8; ++i) { x[j][i] *= 0.125f; mx = fmaxf(mx, fabsf(x[j][i])); } }
#pragma unroll
        for (int o = 1; o < 64; o <<= 1) mx = fmaxf(mx, __shfl_xor(mx, o));
        const float inv = mx > 0.f ? 127.f / mx : 0.f; if (lane == 0) SAC[r] = mx * (1.f / 127.f);
#pragma unroll
        for (int j = 0; j < 8; ++j) { unsigned o2[2];
#pragma unroll
            for (int h2 = 0; h2 < 2; ++h2) o2[h2] = Q4_MAGIC(x[j][4 * h2], x[j][4 * h2 + 1], x[j][4 * h2 + 2], x[j][4 * h2 + 3], inv);
            *(GAS v2u*)(dst + j * 512) = (v2u){o2[0], o2[1]}; }
    }
}
#define OPQ(T, name, expr) T name = (expr); asm volatile("" : "+s"(name))
__device__ __forceinline__ void p10_postmix(Frame& F) {
    CArgs* A = ARGS_PTR(); int tid_ = (int)threadIdx.x; asm volatile("" : "+v"(tid_)); const int lane_ = tid_ & 63;
    const int gw = F.vcu * NWAVES + F.wave, NGW = F.G * NWAVES, lane = lane_;
    const float* MODp = (const float*)(A->ws + WS_MOD); unsigned char* Hq = (unsigned char*)(A->ws + WS_H); float* SAHp = (float*)(A->ws + WS_SAH); const bf16* MIXb = (const bf16*)(A->ws + WS_MIX);
    const float* FOLDp = (const float*)(A->ws + WS_FOLD); bf16* X1b = (bf16*)(A->ws + WS_X1);
    LAS unsigned char* xl = F.lds + F.wave * 16384;
    LAS unsigned char* vst = F.lds + 131072;
    int cur_vi = -1;
#define P10_STAGE(vi_) do { __syncthreads(); \
        _Pragma("unroll") for (int i_ = 0; i_ < 6; ++i_) { const int p_ = tid_ + 512 * i_, v_ = p_ >> 10, c_ = (p_ & 1023) * 4; \
            const float* s_ = v_ == 0 ? FOLDp + (vi_) * 16384 + 4096 : (v_ == 1 ? FOLDp + (vi_) * 16384 + 8192 : MODp + (vi_) * 24576 + 12288); const f32x4 a_ = *(const GAS f32x4*)(s_ + c_); \
            *(LAS v2u*)(vst + v_ * 8192 + c_ * 2) = (v2u){pkbf(a_[0], a_[1]), pkbf(a_[2], a_[3])}; } \
        LDS_WAIT(); __syncthreads(); } while (0)
#define VEC8(dst0, dst1, voff_, j_) do { const v4u q_ = *(const LAS v4u*)(vst + (voff_) + (512 * (j_) + 8 * lane) * 2); \
        dst0 = (f32x4){bflo(q_[0]), bfhi(q_[0]), bflo(q_[1]), bfhi(q_[1])}; dst1 = (f32x4){bflo(q_[2]), bfhi(q_[2]), bflo(q_[3]), bfhi(q_[3])}; } while (0)
#define MLOAD(M, r_) do { OPQ(const bf16*, mr_, MIXb + (size_t)(r_) * DM); _Pragma("unroll") for (int j = 0; j < 8; ++j) M[j] = *(const GAS v4u*)(mr_ + 8 * lane + 512 * j); } while (0)
#define P10_BODY(M, MN, r_) do { const int rr_ = (r_); f32x4 X[16]; \
        const int vi_ = rr_ < MP ? 0 : 1 + ((rr_ - MP) >> 12); \
        if (vi_ != cur_vi) { P10_STAGE(vi_); cur_vi = vi_; } \
        VM_WAIT(); ROW_FROM_LDS8(X, xl); \
        { const int rn_ = rr_ + NGW; if (rn_ < MT) { ROW_PREFETCH(xl, XROW(rn_)); MLOAD(MN, rn_); } } \
        float ss_ = 0.f; \
        _Pragma("unroll") for (int j = 0; j < 8; ++j) { _Pragma("unroll") for (int e = 0; e < 4; ++e) { const float m0 = bflo(M[j][e]), m1 = bfhi(M[j][e]); ss_ += m0 * m0 + m1 * m1; } } \
        const float rstd_ = 1.f / sqrtf(wave_sum(ss_) * (1.f / DM) + RMS_EPS); float ss2_ = 0.f; \
        _Pragma("unroll") for (int jj = 0; jj < 4; ++jj) { OPQ(bf16*, oq_, X1b + (size_t)rr_ * DM + jj * 1024); \
            _Pragma("unroll") for (int j2 = 0; j2 < 2; ++j2) { const int col_ = 8 * lane + 512 * j2, j_ = 2 * jj + j2; f32x4 ga_[2]; VEC8(ga_[0], ga_[1], 0, j_); \
                _Pragma("unroll") for (int hh = 0; hh < 2; ++hh) { const int k_ = 2 * j_ + hh; \
                    const f32x4 mv_ = (f32x4){bflo(M[j_][2 * hh]), bfhi(M[j_][2 * hh]), bflo(M[j_][2 * hh + 1]), bfhi(M[j_][2 * hh + 1])}; \
                    X[k_] = X[k_] + ga_[hh] * (mv_ * rstd_); \
                    ss2_ += (X[k_][0] * X[k_][0] + X[k_][1] * X[k_][1]) + (X[k_][2] * X[k_][2] + X[k_][3] * X[k_][3]); } \
                *(GAS v4u*)(oq_ + col_) = (v4u){pkbf(X[2 * j_][0], X[2 * j_][1]), pkbf(X[2 * j_][2], X[2 * j_][3]), pkbf(X[2 * j_ + 1][0], X[2 * j_ + 1][1]), pkbf(X[2 * j_ + 1][2], X[2 * j_ + 1][3])}; } } \
        const float rstd2_ = 1.f / sqrtf(wave_sum(ss2_) * (1.f / DM) + RMS_EPS); float hm_ = 0.f; \
        _Pragma("unroll") for (int j_ = 0; j_ < 8; ++j_) { f32x4 sc_[2], sh_[2]; VEC8(sc_[0], sc_[1], 8192, j_); VEC8(sh_[0], sh_[1], 16384, j_); \
            _Pragma("unroll") for (int hh = 0; hh < 2; ++hh) { const int k_ = 2 * j_ + hh; \
                X[k_] = (X[k_] * rstd2_) * sc_[hh] + sh_[hh]; \
                hm_ = fmaxf(hm_, fmaxf(fmaxf(fabsf(X[k_][0]), fabsf(X[k_][1])), fmaxf(fabsf(X[k_][2]), fabsf(X[k_][3])))); } } \
        _Pragma("unroll") for (int o_ = 1; o_ < 64; o_ <<= 1) hm_ = fmaxf(hm_, __shfl_xor(hm_, o_)); \
          \
        const float hinv_ = hm_ > 0.f ? 127.f / hm_ : 0.f; if (lane == 0) SAHp[rr_] = hm_ * (1.f / 127.f); \
        { OPQ(unsigned char*, hq_, Hq + (size_t)rr_ * DM); \
            _Pragma("unroll") for (int j = 0; j < 8; ++j) { unsigned w2_[2]; \
                _Pragma("unroll") for (int hh = 0; hh < 2; ++hh) { const int k_ = 2 * j + hh; w2_[hh] = Q4_MAGIC(X[k_][0], X[k_][1], X[k_][2], X[k_][3], hinv_); } \
                *(GAS v2u*)(hq_ + 8 * lane + 512 * j) = (v2u){w2_[0], w2_[1]}; } } } while (0)
    v4u ma[8], mb[8];
    int r = gw; if (r < MT) { ROW_PREFETCH(xl, XROW(r)); MLOAD(ma, r); }
#pragma unroll 1
    for (; r < MT; r += 2 * NGW) { P10_BODY(ma, mb, r); if (r + NGW < MT) P10_BODY(mb, ma, r + NGW); }
#undef P10_BODY
#undef MLOAD
#undef VEC8
#undef P10_STAGE
}
__device__ __forceinline__ void p12_final(Frame& F) {
    CArgs* A = ARGS_PTR(); int tid_ = (int)threadIdx.x; asm volatile("" : "+v"(tid_)); const int lane_ = tid_ & 63;
    const int gw = F.vcu * NWAVES + F.wave, NGW = F.G * NWAVES, lane = lane_;
    const float* FOLDp = (const float*)(A->ws + WS_FOLD); const bf16* MO = (const bf16*)(A->ws + WS_MOUT); const bf16* X1b = (const bf16*)(A->ws + WS_X1); float* outp = A->out;
    LAS unsigned char* xl = F.lds + F.wave * 16384;
#define X1_PREFETCH(r_) do { const char* g_ = (const char*)(X1b + (size_t)(r_) * DM) + lane * 16; \
        _Pragma("unroll") for (int j = 0; j < 8; ++j) __builtin_amdgcn_global_load_lds((const unsigned*)(g_ + j * 1024), (LAS unsigned*)(xl + j * 1024), 16, 0, 0); } while (0)
#define MLOAD(M, r_) do { OPQ(const bf16*, mr_, MO + (size_t)(r_) * DM); _Pragma("unroll") for (int j = 0; j < 8; ++j) M[j] = *(const GAS v4u*)(mr_ + 8 * lane + 512 * j); } while (0)
    LAS unsigned char* vst = F.lds + 131072; int cur_vi = -1;
#define P12_STAGE(vi_) do { __syncthreads(); \
        _Pragma("unroll") for (int i_ = 0; i_ < 2; ++i_) { const int c_ = (tid_ + 512 * i_) * 4; *(LAS f32x4*)(vst + c_ * 4) = *(const GAS f32x4*)(FOLDp + (vi_) * 16384 + 12288 + c_); } \
        LDS_WAIT(); __syncthreads(); } while (0)
#define P12_BODY(M, MN, r_) do { const int rr_ = (r_); v4u X[8]; \
        const int vi_ = rr_ < MP ? 0 : 1 + ((rr_ - MP) >> 12); if (vi_ != cur_vi) { P12_STAGE(vi_); cur_vi = vi_; } \
        VM_WAIT(); _Pragma("unroll") for (int j = 0; j < 8; ++j) X[j] = *(const LAS v4u*)(xl + j * 1024 + lane * 16); LDS_WAIT(); \
        { const int rn_ = rr_ + NGW; if (rn_ < MT) { X1_PREFETCH(rn_); MLOAD(MN, rn_); } } \
        float ss_ = 0.f; \
        _Pragma("unroll") for (int j = 0; j < 8; ++j) { _Pragma("unroll") for (int e = 0; e < 4; ++e) { const float m0 = bflo(M[j][e]), m1 = bfhi(M[j][e]); ss_ += m0 * m0 + m1 * m1; } } \
        const float rstd_ = 1.f / sqrtf(wave_sum(ss_) * (1.f / DM) + RMS_EPS); \
        _Pragma("unroll") for (int jj = 0; jj < 4; ++jj) { OPQ(float*, oq_, outp + (size_t)rr_ * DM + jj * 1024); \
            _Pragma("unroll") for (int j2 = 0; j2 < 2; ++j2) { const int col_ = 8 * lane + 512 * j2, k_ = 2 * jj + j2; \
                _Pragma("unroll") for (int hh = 0; hh < 2; ++hh) { \
                    const f32x4 gm_ = *(const LAS f32x4*)(vst + (jj * 1024 + col_ + 4 * hh) * 4); \
                    const f32x4 mv_ = (f32x4){bflo(M[k_][2 * hh]), bfhi(M[k_][2 * hh]), bflo(M[k_][2 * hh + 1]), bfhi(M[k_][2 * hh + 1])}; \
                    const f32x4 xv_ = (f32x4){bflo(X[k_][2 * hh]), bfhi(X[k_][2 * hh]), bflo(X[k_][2 * hh + 1]), bfhi(X[k_][2 * hh + 1])}; \
                    *(GAS f32x4*)(oq_ + col_ + 4 * hh) = xv_ + gm_ * (mv_ * rstd_); } } } } while (0)
    v4u ma[8], mb[8];
    int r = gw; if (r < MT) { X1_PREFETCH(r); MLOAD(ma, r); }
#pragma unroll 1
    for (; r < MT; r += 2 * NGW) { P12_BODY(ma, mb, r); if (r + NGW < MT) P12_BODY(mb, ma, r + NGW); }
#undef P12_BODY
#undef P12_STAGE
#undef MLOAD
#undef X1_PREFETCH
#undef XROW
}

constexpr int N_PHASES = 13;

__global__ void __launch_bounds__(NWAVES * 64, 2) hymba_fwd(Args args) {
    extern __shared__ __attribute__((aligned(16))) unsigned char lds[];
    Frame F;
    F.lds = (LAS unsigned char*)lds;
    F.tid = threadIdx.x; F.lane = F.tid & 63; F.wave = __builtin_amdgcn_readfirstlane(F.tid >> 6);
    F.G = gridDim.x; { const int bx = blockIdx.x; F.vcu = (F.G % 8 == 0) ? (bx % 8) * (F.G / 8) + bx / 8 : bx; }
    unsigned* const ctl = (unsigned*)(args.ws + WS_CTL);
    for (int u = F.tid; u < (LDS_BYTES - LDSCTL_OFF) / 4; u += NWAVES * 64) ((LAS unsigned*)(F.lds + LDSCTL_OFF))[u] = 0u;
    __syncthreads();
    XcdBarrier bar = xcd_barrier_post(ctl + CW_BAR, (volatile LAS unsigned*)(F.lds + MISC_OFF) + 8);
    const int lo = args.ph_lo, hi = args.ph_hi;
#ifndef ONLY_PHASE
#define ONLY_PHASE -1
#endif
#define IN(k) ((ONLY_PHASE < 0 || ONLY_PHASE == (k)) && lo <= (k) && (k) < hi)
#define SEAM(k) do { if (IN(k) && IN((k) + 1)) xcd_barrier(bar); } while (0)
#ifndef PROBE_MASK
#define PROBE_MASK 0
#endif
#define NREP(k) (((PROBE_DUP == (k)) || ((PROBE_MASK >> (k)) & 1)) ? 2 : 1)

    for (int rep = 0; rep < NREP(0); ++rep) { if (rep) xcd_barrier(bar); if (IN(0)) p0_prologue(F); }
    SEAM(0);
    for (int rep = 0; rep < NREP(1); ++rep) { if (rep) xcd_barrier(bar); if (IN(1)) p1_mod(F); }
    SEAM(1);
    for (int rep = 0; rep < NREP(2); ++rep) { if (rep) xcd_barrier(bar); if (IN(2)) p2_h(F); }
    SEAM(2);
    for (int rep = 0; rep < NREP(3); ++rep) { if (rep) xcd_barrier(bar);
    if (IN(3)) {
#define EPI_IN(pn0_, row0_) pg8::EpiIn{((bf16*)(args.ws + WS_KP)), ((bf16*)(args.ws + WS_KS)), ((bf16*)(args.ws + WS_VP)), ((bf16*)(args.ws + WS_VS)), ((bf16*)(args.ws + WS_XR)), ((float*)(args.ws + WS_DT)), (args.out) + O_NK, (args.out) + O_NV, pn0_, row0_}
        {   pg8::Gemm g{((bf16*)(args.ws + WS_H)), ((bf16*)(args.ws + WS_WIN)) + (size_t)4096 * DM, MP, NINB - 4096, DM}; pg8::StaticOrder S; S.init(MP, NINB - 4096, F.G, (int)blockIdx.x);
            pg8::EpiIn E = EPI_IN(16, 0); pg8::gemm_phase<pg8::EpiIn, pg8::StaticOrder, true, true>(F.lds, g, S, E); }
        {   pg8::Gemm g{((bf16*)(args.ws + WS_H)) + (size_t)MP * DM, ((bf16*)(args.ws + WS_WIN)) + (size_t)7168 * DM, MS, 256, DM}; pg8::StaticOrder S; S.init(MS, 256, F.G, (int)(F.G - 1 - blockIdx.x));
            pg8::EpiIn E = EPI_IN(28, MP); pg8::gemm_phase<pg8::EpiIn, pg8::StaticOrder, true, true>(F.lds, g, S, E); }
#undef EPI_IN
        {   pg8::Gemm g{(const pg8::bf16_t*)(args.ws + WS_HQ), (const pg8::bf16_t*)(args.ws + WS_WINQ), MT, DM, DM / 2}; pg8::StaticOrder S; S.init(MT, DM, F.G, (int)(F.G - 1 - blockIdx.x));
            pg8::EpiQZ E{((bf16*)(args.ws + WS_Q)), ((bf16*)(args.ws + WS_Z)), (const float*)(args.ws + WS_SAHI), (const float*)(args.ws + WS_SBI)};
            pg8::gemm_phase_i8<pg8::EpiQZ, pg8::StaticOrder, true, true>(F.lds, g, S, E); }
        {   pg8::Gemm g{(const pg8::bf16_t*)(args.ws + WS_HQ), (const pg8::bf16_t*)(args.ws + WS_WINQ + (size_t)4096 * DM), MT, DM, DM / 2}; pg8::StaticOrder S; S.init(MT, DM, F.G, (int)blockIdx.x);
            pg8::EpiKVa E{((bf16*)(args.ws + WS_KP)), ((bf16*)(args.ws + WS_KS)), ((bf16*)(args.ws + WS_VP)), ((bf16*)(args.ws + WS_VS)), (args.out) + O_NK, (args.out) + O_NV, (const float*)(args.ws + WS_SAHI), (const float*)(args.ws + WS_SBI) + 4096};
            pg8::gemm_phase_i8<pg8::EpiKVa, pg8::StaticOrder, true, true>(F.lds, g, S, E); }
        {   pg8::Gemm g{(const pg8::bf16_t*)(args.ws + WS_HQ + (size_t)MP * DM), (const pg8::bf16_t*)(args.ws + WS_WINQ + (size_t)8192 * DM), MS, 3072, DM / 2}; pg8::StaticOrder S; S.init(MS, 3072, F.G, (int)blockIdx.x);
            pg8::EpiXs E{((bf16*)(args.ws + WS_XR)) + (size_t)MP * 3072, (const float*)(args.ws + WS_SAHI) + MP, (const float*)(args.ws + WS_SBI) + 8192};
            pg8::gemm_phase_i8<pg8::EpiXs, pg8::StaticOrder, true, true>(F.lds, g, S, E); }
    } }
    SEAM(3);
    if (IN(4)) p4_rope_conv(F);
    SEAM(4);
    for (int rep = 0; rep < NREP(5); ++rep) { if (rep) xcd_barrier(bar); if (IN(5)) p5_states(F); }
    SEAM(5);
    if (IN(6)) { p6_scan(F); }
    if (IN(7)) { __syncthreads(); p7_attention(F, (char*)lds); }
    SEAM(7);
    for (int rep = 0; rep < NREP(8); ++rep) { if (rep) xcd_barrier(bar); if (IN(8)) p8_ssd_out(F); }
    SEAM(8);
    if (IN(9)) {
        p9a_quant_cat(F);
        xcd_barrier(bar);
        pg8::Gemm g{(const pg8::bf16_t*)(args.ws + WS_CATQ), (const pg8::bf16_t*)(args.ws + WS_WOUTQ), MT, DM, DM / 2}; pg8::StaticOrder S; S.init(MT, DM, F.G, (int)blockIdx.x);
        pg8::EpiMixI8 E{((bf16*)(args.ws + WS_MIX)), DM, (const float*)(args.ws + WS_SAC), (const float*)(args.ws + WS_SBO)};
        pg8::gemm_phase_i8<pg8::EpiMixI8, pg8::StaticOrder, true, true>(F.lds, g, S, E);
    }
    SEAM(9);
    for (int rep = 0; rep < NREP(10); ++rep) { if (rep) xcd_barrier(bar); if (IN(10)) p10_postmix(F); }
    SEAM(10);
    for (int rep = 0; rep < NREP(11); ++rep) { if (rep) xcd_barrier(bar);
    if (IN(11)) {
#pragma unroll 1
        for (int step = 0; step <= N_MLP_CH; ++step) {
            if (step > 0) { const int ch = step - 1;
                pg8::Gemm g{(const pg8::bf16_t*)(args.ws + WS_UPQ), (const pg8::bf16_t*)(args.ws + WS_WDN), MLP_CH, DM, DFF / 2}; pg8::StaticOrder S; S.init(MLP_CH, DM, F.G, (int)blockIdx.x);
                pg8::EpiDownI8 E{((bf16*)(args.ws + WS_MOUT)) + (size_t)ch * MLP_CH * DM, DM, (const float*)(args.ws + WS_SA) + ch * MLP_CH, (const float*)(args.ws + WS_SB), (const int*)(args.ws + WS_CTL) + CW_CS};
                pg8::gemm_phase_i8<pg8::EpiDownI8, pg8::StaticOrder, true, true>(F.lds, g, S, E); }
            if (step < N_MLP_CH) {
                {   pg8::Gemm g{(const pg8::bf16_t*)(args.ws + WS_H + (size_t)step * MLP_CH * DM), (const pg8::bf16_t*)(args.ws + WS_WUP), MLP_CH, DFF, DM / 2}; pg8::StaticOrder S; S.init(MLP_CH, DFF, F.G, (int)blockIdx.x);
                    pg8::EpiUpI8L E{(unsigned char*)(args.ws + WS_UPQ), DFF, (float*)(args.ws + WS_UP), (const float*)(args.ws + WS_SAH) + step * MLP_CH, (const float*)(args.ws + WS_SBU)};
                    pg8::gemm_phase_i8<pg8::EpiUpI8L, pg8::StaticOrder, true, true>(F.lds, g, S, E); }
                xcd_barrier(bar);
                p11_requant(F, step, (unsigned char*)(args.ws + WS_UPQ), (const float*)(args.ws + WS_UP));
                xcd_barrier(bar); }
        }
    } }
    SEAM(11);
    if (IN(12)) p12_final(F);
#undef IN
#undef SEAM
}

extern "C" void kernel_launch(void* const* d_in, const int* in_sizes, int n_in, void* d_out, int out_size, void* d_ws, size_t ws_size, hipStream_t stream) {
    static int grid = 0;
    if (grid == 0) {
        if (n_in != 29 || (size_t)out_size != OUT_TOTAL || ws_size < WS_END) { fprintf(stderr, "kernel_launch: unexpected shapes: n_in %d out %d ws %zu (need %zu)\n", n_in, out_size, ws_size, (size_t)WS_END); grid = -1; return; }
        int dev = 0, cus = 0;
        if (hipGetDevice(&dev) != hipSuccess || hipDeviceGetAttribute(&cus, hipDeviceAttributeMultiprocessorCount, dev) != hipSuccess) { grid = -1; return; }
        if (hipFuncSetAttribute((const void*)hymba_fwd, hipFuncAttributeMaxDynamicSharedMemorySize, LDS_BYTES) != hipSuccess) { fprintf(stderr, "kernel_launch: hipFuncSetAttribute failed\n"); grid = -1; return; }
        int per_cu = 0;
        if (hipOccupancyMaxActiveBlocksPerMultiprocessor(&per_cu, (const void*)hymba_fwd, NWAVES * 64, LDS_BYTES) != hipSuccess || per_cu < 1) fprintf(stderr, "kernel_launch: occupancy query says %d\n", per_cu);
        (void)hipGetLastError();
        grid = cus;
    }
    if (grid < 0) return;
    if (hipMemsetAsync((char*)d_ws + WS_CTL, 0, CTL_ZERO_BYTES, stream) != hipSuccess) return;
    Args a{};
    for (int i = 0; i < 29; ++i) a.in[i] = (const float*)d_in[i];
    a.out = (float*)d_out; a.ws = (unsigned char*)d_ws; a.ph_lo = 0; a.ph_hi = N_PHASES;
    hipLaunchKernelGGL(hymba_fwd, dim3(grid), dim3(NWAVES * 64), LDS_BYTES, stream, a);
    const hipError_t le = hipPeekAtLastError();
    if (le != hipSuccess) fprintf(stderr, "kernel_launch: launch failed: %s\n", hipGetErrorName(le));
}
```
